# Optimizing an MI355X kernel written in HIP

```python
import math
import jax, jax.numpy as jnp
from jax import lax
import numpy as np

D_MODEL = 1024
BATCH = 4
SEQ = 8192
DEPTH = 2

D_MIX = D_MODEL
SSM_WIDTH = D_MIX // 2
POOL_WIDTH = D_MIX // 4
CONV_WIDTH = D_MIX - SSM_WIDTH - POOL_WIDTH
SSM_GROUP = 16
SSM_GROUPS = SSM_WIDTH // SSM_GROUP
SSM_STATE = 64
STEP_MIN = 1e-3
STEP_MAX = 1e-1
LAMBDA_RE_MAX = -1e-4
POOL_WINDOWS = (2, 4, 8, 16)
POOL_GROUP = POOL_WIDTH // len(POOL_WINDOWS)
CONV_K = 3
IN_WIDTH = SSM_WIDTH + POOL_WIDTH + 3 * CONV_WIDTH
N_EXPERTS = 32
TOP_K = 4
D_EXPERT = D_MODEL
SWIGLU_LIMIT = 7.0
SWIGLU_ALPHA = 1.702
EXPERT_BLOCK = 256
NORM_EPS = 1e-5

kernel_name = 'hymba_s5_pool_shortconv_moe'


def rmsnorm(x, g):
    xf = x.astype(jnp.float32)
    r = lax.rsqrt(jnp.mean(xf * xf, axis=-1, keepdims=True) + NORM_EPS)
    return (xf * r).astype(x.dtype) * g


def _complex_linear_combine(e1, e2):
    a1r, a1i, b1r, b1i = e1
    a2r, a2i, b2r, b2i = e2
    ar = a2r * a1r - a2i * a1i
    ai = a2r * a1i + a2i * a1r
    br = a2r * b1r - a2i * b1i + b2r
    bi = a2r * b1i + a2i * b1r + b2i
    return (ar, ai, br, bi)


def s5_mixer(u, lam_re, lam_im, b_re, b_im, c_re, c_im, d_skip, log_step, w_glu, b_glu):
    f32 = jnp.float32
    bsz, L, _ = u.shape
    uf = u.astype(f32)
    ug = uf.reshape(bsz, L, SSM_GROUPS, SSM_GROUP)
    lr = jnp.minimum(lam_re.astype(f32), LAMBDA_RE_MAX)
    li = lam_im.astype(f32)
    step = jnp.exp(log_step.astype(f32))[:, None]
    mag = jnp.exp(lr * step)
    ar = mag * jnp.cos(li * step)
    ai = mag * jnp.sin(li * step)
    nr = ar - 1.0
    den = lr * lr + li * li
    kr = (nr * lr + ai * li) / den
    ki = (ai * lr - nr * li) / den
    bre = b_re.astype(f32)
    bim = b_im.astype(f32)
    bbar_r = kr[..., None] * bre - ki[..., None] * bim
    bbar_i = kr[..., None] * bim + ki[..., None] * bre
    bu_r = jnp.einsum('blgh,gph->blgp', ug, bbar_r)
    bu_i = jnp.einsum('blgh,gph->blgp', ug, bbar_i)
    a_r = jnp.broadcast_to(ar[None, None], (1, L, SSM_GROUPS, SSM_STATE))
    a_i = jnp.broadcast_to(ai[None, None], (1, L, SSM_GROUPS, SSM_STATE))
    _, _, h_r, h_i = lax.associative_scan(_complex_linear_combine, (a_r, a_i, bu_r, bu_i), axis=1)
    y = (jnp.einsum('blgp,ghp->blgh', h_r, c_re.astype(f32))
         - jnp.einsum('blgp,ghp->blgh', h_i, c_im.astype(f32)))
    y = y.reshape(bsz, L, SSM_WIDTH) + d_skip.astype(f32) * uf
    z = jax.nn.gelu(y)
    out = z * jax.nn.sigmoid(z @ w_glu.astype(f32) + b_glu.astype(f32))
    return out.astype(u.dtype)


def causal_window_mean(z, w):
    L = z.shape[1]
    cs = jnp.cumsum(z, axis=1)
    cs_pad = jnp.pad(cs, ((0, 0), (w, 0), (0, 0)))
    total = cs_pad[:, w:] - cs_pad[:, :L]
    count = jnp.minimum(jnp.arange(1, L + 1), w).astype(jnp.float32)
    return total / count[None, :, None]


def pool_mixer(p, pool_w, pool_scale):
    f32 = jnp.float32
    bsz, L, _ = p.shape
    pf = p.astype(f32).reshape(bsz, L, len(POOL_WINDOWS), POOL_GROUP)
    pooled = jnp.stack([causal_window_mean(pf[:, :, i], w) - pf[:, :, i]
                        for i, w in enumerate(POOL_WINDOWS)], axis=2)
    mixed = jnp.einsum('blgc,gcd->blgd', pooled, pool_w.astype(f32)).reshape(bsz, L, POOL_WIDTH)
    return (mixed * pool_scale.astype(f32)).astype(p.dtype)


def short_conv_mixer(bg, cg, hv, conv_w):
    L = hv.shape[1]
    z = cg * hv
    zp = jnp.pad(z, ((0, 0), (CONV_K - 1, 0), (0, 0)))
    y = conv_w[0] * zp[:, 0:L]
    for k in range(1, CONV_K):
        y = y + conv_w[k] * zp[:, k:k + L]
    return bg * y


def moe_ffn(h, router_w, router_b, w_gu, b_gu, w_dn, b_dn):
    bsz, L, D = h.shape
    N = bsz * L
    NK = N * TOP_K
    x = h.reshape(N, D)
    logits = (x @ router_w + router_b).astype(jnp.float32)
    top_vals, top_idx = lax.top_k(logits, TOP_K)
    gates = jax.nn.softmax(top_vals, axis=-1)
    flat_e = top_idx.reshape(NK).astype(jnp.int32)
    flat_tok = jnp.arange(NK, dtype=jnp.int32) // TOP_K
    flat_gate = gates.reshape(NK)
    order = jnp.argsort(flat_e)
    sorted_e = flat_e[order]
    counts = jnp.bincount(flat_e, length=N_EXPERTS).astype(jnp.int32)
    padded = (counts + EXPERT_BLOCK - 1) // EXPERT_BLOCK * EXPERT_BLOCK
    padded_end = jnp.cumsum(padded)
    padded_start = padded_end - padded
    start = jnp.cumsum(counts) - counts
    dest = padded_start[sorted_e] + jnp.arange(NK, dtype=jnp.int32) - start[sorted_e]
    n_blocks = -(-(NK + N_EXPERTS * (EXPERT_BLOCK - 1)) // EXPERT_BLOCK)
    R = n_blocks * EXPERT_BLOCK
    row_tok = jnp.full((R,), N, jnp.int32).at[dest].set(flat_tok[order])
    row_gate = jnp.zeros((R,), jnp.float32).at[dest].set(flat_gate[order])
    block_start = jnp.arange(n_blocks, dtype=jnp.int32) * EXPERT_BLOCK
    block_e = jnp.minimum(jnp.searchsorted(padded_end, block_start, side='right'), N_EXPERTS - 1)
    x_pad = jnp.concatenate([x, jnp.zeros((1, D), x.dtype)], axis=0)
    xs = x_pad[row_tok].reshape(n_blocks, EXPERT_BLOCK, D)

    def expert_block(args):
        xb, e = args
        gu = xb @ w_gu[e] + b_gu[e]
        gate = jnp.minimum(gu[:, :D_EXPERT], SWIGLU_LIMIT)
        up = jnp.clip(gu[:, D_EXPERT:], -SWIGLU_LIMIT, SWIGLU_LIMIT)
        act = gate * jax.nn.sigmoid(SWIGLU_ALPHA * gate) * (up + 1.0)
        return act @ w_dn[e] + b_dn[e]

    ys = lax.map(expert_block, (xs, block_e)).reshape(R, D)
    ys = ys * row_gate[:, None].astype(ys.dtype)
    out = jax.ops.segment_sum(ys, row_tok, num_segments=N + 1)[:N]
    return out.reshape(bsz, L, D)


def setup_inputs(seed: int = 0) -> dict:
    key = jax.random.key(seed)
    ks = jax.random.split(key, 28)
    f32 = jnp.float32

    def nrm(k, shape, scale):
        return scale * jax.random.normal(k, shape, f32)

    G, P, H = SSM_GROUPS, SSM_STATE, SSM_GROUP
    return {
        'x': nrm(ks[0], (BATCH, SEQ, D_MODEL), 1.0),
        'norm_mix': 1.0 + nrm(ks[1], (DEPTH, D_MODEL), 0.02),
        'w_in': nrm(ks[2], (DEPTH, D_MODEL, IN_WIDTH), D_MODEL ** -0.5),
        'ssm_lam_re': -0.5 + nrm(ks[3], (DEPTH, G, P), 0.01),
        'ssm_lam_im': math.pi * jnp.arange(P, dtype=f32) + nrm(ks[4], (DEPTH, G, P), 0.01),
        'ssm_b_re': nrm(ks[5], (DEPTH, G, P, H), (2 * H) ** -0.5),
        'ssm_b_im': nrm(ks[6], (DEPTH, G, P, H), (2 * H) ** -0.5),
        'ssm_c_re': nrm(ks[7], (DEPTH, G, H, P), (2 * P) ** -0.5),
        'ssm_c_im': nrm(ks[8], (DEPTH, G, H, P), (2 * P) ** -0.5),
        'ssm_d': nrm(ks[9], (DEPTH, SSM_WIDTH), 1.0),
        'ssm_log_step': jax.random.uniform(ks[10], (DEPTH, G), f32, math.log(STEP_MIN), math.log(STEP_MAX)),
        'ssm_w_glu': nrm(ks[11], (DEPTH, SSM_WIDTH, SSM_WIDTH), SSM_WIDTH ** -0.5),
        'ssm_b_glu': nrm(ks[12], (DEPTH, SSM_WIDTH), 0.02),
        'pool_w': nrm(ks[13], (DEPTH, len(POOL_WINDOWS), POOL_GROUP, POOL_GROUP), POOL_GROUP ** -0.5),
        'pool_scale': 1.0 + nrm(ks[14], (DEPTH, POOL_WIDTH), 0.1),
        'conv_w': nrm(ks[15], (DEPTH, CONV_K, CONV_WIDTH), CONV_K ** -0.5),
        'branch_norm': 1.0 + nrm(ks[16], (DEPTH, D_MIX), 0.02),
        'w_out': nrm(ks[17], (DEPTH, D_MIX, D_MODEL), D_MIX ** -0.5),
        'norm_ffn': 1.0 + nrm(ks[18], (DEPTH, D_MODEL), 0.02),
        'router_w': nrm(ks[19], (DEPTH, D_MODEL, N_EXPERTS), D_MODEL ** -0.5),
        'router_b': nrm(ks[20], (DEPTH, N_EXPERTS), 0.01),
        'w_gate_up': nrm(ks[21], (DEPTH, N_EXPERTS, D_MODEL, 2 * D_EXPERT), D_MODEL ** -0.5),
        'b_gate_up': nrm(ks[22], (DEPTH, N_EXPERTS, 2 * D_EXPERT), 0.02),
        'w_down': nrm(ks[23], (DEPTH, N_EXPERTS, D_EXPERT, D_MODEL), D_EXPERT ** -0.5),
        'b_down': nrm(ks[24], (DEPTH, N_EXPERTS, D_MODEL), 0.02),
        'final_norm': 1.0 + nrm(ks[25], (D_MODEL,), 0.02),
    }


def reference(x, norm_mix, w_in, ssm_lam_re, ssm_lam_im, ssm_b_re, ssm_b_im, ssm_c_re, ssm_c_im,
              ssm_d, ssm_log_step, ssm_w_glu, ssm_b_glu, pool_w, pool_scale, conv_w, branch_norm,
              w_out, norm_ffn, router_w, router_b, w_gate_up, b_gate_up, w_down, b_down, final_norm):
    s0 = SSM_WIDTH
    s1 = s0 + POOL_WIDTH
    splits = [s0, s1, s1 + CONV_WIDTH, s1 + 2 * CONV_WIDTH]
    for l in range(DEPTH):
        hn = rmsnorm(x, norm_mix[l])
        proj = hn @ w_in[l]
        u, p, bg, cg, hv = jnp.split(proj, splits, axis=-1)
        y_ssm = s5_mixer(u, ssm_lam_re[l], ssm_lam_im[l], ssm_b_re[l], ssm_b_im[l],
                         ssm_c_re[l], ssm_c_im[l], ssm_d[l], ssm_log_step[l],
                         ssm_w_glu[l], ssm_b_glu[l])
        y_pool = pool_mixer(p, pool_w[l], pool_scale[l])
        y_conv = short_conv_mixer(bg, cg, hv, conv_w[l])
        g = branch_norm[l]
        mixed = jnp.concatenate([rmsnorm(y_ssm, g[:s0]),
                                 rmsnorm(y_pool, g[s0:s1]),
                                 rmsnorm(y_conv, g[s1:])], axis=-1)
        x = x + mixed @ w_out[l]
        x = x + moe_ffn(rmsnorm(x, norm_ffn[l]), router_w[l], router_b[l],
                        w_gate_up[l], b_gate_up[l], w_down[l], b_down[l])
    return rmsnorm(x, final_norm)
```

```cpp
#include <hip/hip_runtime.h>
#include <cstdio>
#include <cstdint>

#ifndef MK_ONE_LAUNCH
#define MK_ONE_LAUNCH 1
#endif
#ifndef LDS_FULLLINE
#define LDS_FULLLINE 1
#endif
#ifndef GU_FP6
#define GU_FP6 1
#endif
#ifndef PROBE_FLAGS
#define PROBE_FLAGS 0
#endif
#ifndef DBG_SKIP
#define DBG_SKIP 0
#endif

#define GAS __attribute__((address_space(1)))
#define LAS __attribute__((address_space(3)))
typedef unsigned short bf16;
typedef short bf16x8 __attribute__((ext_vector_type(8)));
typedef float f32x4 __attribute__((ext_vector_type(4)));
typedef float f32x2 __attribute__((ext_vector_type(2)));
typedef unsigned u32x4 __attribute__((ext_vector_type(4)));
typedef unsigned u32x2 __attribute__((ext_vector_type(2)));
typedef int v8i __attribute__((ext_vector_type(8)));
typedef int v4i __attribute__((ext_vector_type(4)));

constexpr int NTOK = 32768, DM = 1024, SEQ = 8192, NBATCH = 4, INW = 1536, NE = 32, TOPK = 4, DEPTH = 2;
constexpr int SSMW = 512, NG = 32, SP = 64, CH = 32, NCH = SEQ / CH, NCOL = NBATCH * NCH, UK = 640, ULD = NG * UK;
constexpr float EPS = 1e-5f;
constexpr int NWAVES = 8, NTHREADS = 512;
constexpr int ROWCAP = 32768;
constexpr int MAXMB = NTOK * TOPK / 256 + NE;

constexpr size_t MiB = 1u << 20;
constexpr size_t WS_CTL = 0, CTL_ZERO_BYTES = 1 * MiB;
constexpr size_t WS_RSTD0 = 1 * MiB;
constexpr size_t WS_RSTD1 = WS_RSTD0 + 128 * 1024;
constexpr size_t WS_GATE = WS_RSTD1 + 128 * 1024;
constexpr size_t WS_SSQP = 2 * MiB;
constexpr size_t WS_ROWL = 3 * MiB;
constexpr size_t WS_WR = 7 * MiB;
constexpr size_t WS_SSMA = WS_WR + 256 * 1024;
constexpr size_t WS_SSMB = WS_SSMA + 64 * 1024;
constexpr size_t WS_S = 8 * MiB;
constexpr size_t WS_XA = 24 * MiB;
constexpr size_t WS_XB = WS_XA + 128 * MiB;
constexpr size_t WS_XBF = WS_XB + 128 * MiB;
constexpr size_t WS_XBF1 = WS_XBF + 64 * MiB;
constexpr size_t WS_PROJ = WS_XBF1 + 64 * MiB;
constexpr size_t WS_Z = WS_PROJ + 96 * MiB;
constexpr size_t WS_MIX = WS_Z + 32 * MiB;
constexpr size_t WS_H = WS_MIX + 64 * MiB;
constexpr size_t WS_Y = WS_H + 272 * MiB;
constexpr size_t WS_W = WS_Y + 256 * MiB;
constexpr size_t WL_IN = 0, WL_GLU = 3 * MiB, WL_OUT = 4 * MiB, WL_GU = 6 * MiB, WL_DN = 134 * MiB, WL_STRIDE = 198 * MiB;
constexpr size_t WS_UB = WS_W + 2 * WL_STRIDE;
constexpr size_t WS_APOW = WS_UB + 40 * MiB;
constexpr size_t WS_KTAB = WS_APOW + 2 * MiB;
constexpr size_t WS_TZ = WS_KTAB + 2 * MiB;
constexpr size_t WS_PZ = WS_TZ + 40 * MiB;
constexpr size_t WS_ROWG = WS_PZ + 20 * MiB;
constexpr size_t WS_ROWR = WS_ROWG + 4 * MiB;
constexpr size_t WS_XQ = WS_ROWR + 4 * MiB;
constexpr size_t WS_END = WS_XQ + 32 * MiB;
constexpr float Y8_SCALE = 16.0f, Y8_INV = 1.0f / 16.0f;
constexpr float W8_SCALE = 64.0f, W8_INV = 1.0f / 64.0f;
constexpr int CW_BAR = 1024;
constexpr int CW_CNT = 8192;
constexpr int CW_CMAX = 16384;
constexpr size_t WS_SWIN = WS_RSTD1;
constexpr size_t WS_FOLD = WS_XA;

constexpr int RING_BYTES = 131072;
constexpr int MISC_OFF = 135168;
constexpr int LDS_BYTES = 147456;
constexpr int SPITCH = 132;

__device__ __forceinline__ unsigned pk2(float lo, float hi) { unsigned r; asm("v_cvt_pk_bf16_f32 %0, %1, %2" : "=v"(r) : "v"(lo), "v"(hi)); return r; }
__device__ __forceinline__ unsigned pk4_fp8(float a, float b, float c, float d) { int w = 0; w = __builtin_amdgcn_cvt_pk_fp8_f32(a, b, w, false); w = __builtin_amdgcn_cvt_pk_fp8_f32(c, d, w, true); return (unsigned)w; }
__device__ __forceinline__ float bflo(unsigned w) { return __uint_as_float(w << 16); }
__device__ __forceinline__ float bfhi(unsigned w) { return __uint_as_float(w & 0xffff0000u); }
__device__ __forceinline__ float bf1(bf16 b) { return __uint_as_float(((unsigned)b) << 16); }
__device__ __forceinline__ int lane_id_now() { int l; asm volatile("v_mbcnt_lo_u32_b32 %0, -1, 0\n\tv_mbcnt_hi_u32_b32 %0, -1, %0" : "=v"(l)); return l; }
__device__ __forceinline__ float shx(float v, int m, int lane) { return __builtin_bit_cast(float, __builtin_amdgcn_ds_bpermute((lane ^ m) << 2, __builtin_bit_cast(int, v))); }
__device__ __forceinline__ int shxi(int v, int m, int lane) { return __builtin_amdgcn_ds_bpermute((lane ^ m) << 2, v); }
__device__ __forceinline__ float shl_(float v, int src) { return __builtin_bit_cast(float, __builtin_amdgcn_ds_bpermute(src << 2, __builtin_bit_cast(int, v))); }
__device__ __forceinline__ float wave_sum(float v) { const int ln = lane_id_now();
#pragma unroll
    for (int o = 1; o < 64; o <<= 1) v += shx(v, o, ln);
    return v;
}
__device__ __forceinline__ float dpp_shr(float v, int ctrl_sel) { const int iv = __builtin_bit_cast(int, v); int r;
    switch (ctrl_sel) { case 1: r = __builtin_amdgcn_update_dpp(0, iv, 0x111, 0xf, 0xf, true); break; case 2: r = __builtin_amdgcn_update_dpp(0, iv, 0x112, 0xf, 0xf, true); break;
                        case 4: r = __builtin_amdgcn_update_dpp(0, iv, 0x114, 0xf, 0xf, true); break; default: r = __builtin_amdgcn_update_dpp(0, iv, 0x118, 0xf, 0xf, true); break; }
    return __builtin_bit_cast(float, r); }
__device__ __forceinline__ float wave_sum_dpp(float v) {
    v += dpp_shr(v, 1); v += dpp_shr(v, 2); v += dpp_shr(v, 4); v += dpp_shr(v, 8);
    v += __builtin_bit_cast(float, __builtin_amdgcn_update_dpp(0, __builtin_bit_cast(int, v), 0x142, 0xa, 0xf, false));
    v += __builtin_bit_cast(float, __builtin_amdgcn_update_dpp(0, __builtin_bit_cast(int, v), 0x143, 0xc, 0xf, false));
    return __builtin_bit_cast(float, __builtin_amdgcn_readlane(__builtin_bit_cast(int, v), 63));
}
__device__ __forceinline__ unsigned pk4_i8(float a, float b, float c, float d) {
    const int ia = (int)fminf(fmaxf(__builtin_rintf(a), -127.f), 127.f), ib = (int)fminf(fmaxf(__builtin_rintf(b), -127.f), 127.f);
    const int ic = (int)fminf(fmaxf(__builtin_rintf(c), -127.f), 127.f), id = (int)fminf(fmaxf(__builtin_rintf(d), -127.f), 127.f);
    return (unsigned)(ia & 0xff) | ((unsigned)(ib & 0xff) << 8) | ((unsigned)(ic & 0xff) << 16) | ((unsigned)(id & 0xff) << 24);
}
__device__ __forceinline__ float wave_max_dpp(float v) {
    v = fmaxf(v, dpp_shr(v, 1)); v = fmaxf(v, dpp_shr(v, 2)); v = fmaxf(v, dpp_shr(v, 4)); v = fmaxf(v, dpp_shr(v, 8));
    v = fmaxf(v, __builtin_bit_cast(float, __builtin_amdgcn_update_dpp(0, __builtin_bit_cast(int, v), 0x142, 0xa, 0xf, false)));
    v = fmaxf(v, __builtin_bit_cast(float, __builtin_amdgcn_update_dpp(0, __builtin_bit_cast(int, v), 0x143, 0xc, 0xf, false)));
    return __builtin_bit_cast(float, __builtin_amdgcn_readlane(__builtin_bit_cast(int, v), 63));
}
__device__ __forceinline__ float wave_max(float v) { const int ln = lane_id_now();
#pragma unroll
    for (int o = 1; o < 64; o <<= 1) v = fmaxf(v, shx(v, o, ln));
    return v;
}
__device__ __forceinline__ int wave_min_i(int v) { const int ln = lane_id_now();
#pragma unroll
    for (int o = 1; o < 64; o <<= 1) { const int t = shxi(v, o, ln); v = t < v ? t : v; }
    return v;
}
__device__ __forceinline__ float fast_sigmoid(float x) { return __builtin_amdgcn_rcpf(1.0f + __expf(-x)); }
#define LDS_WAIT() asm volatile("s_waitcnt lgkmcnt(0)" ::: "memory")
#define VM_WAIT() asm volatile("s_waitcnt vmcnt(0)" ::: "memory")

#define XB_TMO      128
#define XB_XCNT(j)  (256  + 64 * (j))
#define XB_XSUB(j)  (1280 + 64 * (j))
#define XB_XGEN(j)  (2304 + 64 * (j))
#define XB_TOP      3328
#define XB_TOPGEN   3392
#define XCD_BAR_WORDS 3456
#define XB_SPIN_CAP (1u << 22)
__device__ __forceinline__ unsigned xb_ld(unsigned* p)              { return __hip_atomic_load(p, __ATOMIC_RELAXED, __HIP_MEMORY_SCOPE_AGENT); }
__device__ __forceinline__ unsigned xb_add(unsigned* p, unsigned v) { return __hip_atomic_fetch_add(p, v, __ATOMIC_RELAXED, __HIP_MEMORY_SCOPE_AGENT); }
__device__ __forceinline__ unsigned xb_xcc_id() { return (unsigned)__builtin_amdgcn_s_getreg((3 << 11) | 20) & 0xFu; }
#define XB_SPIN(cond, bar) do { unsigned _sp = 0; while (cond) { __builtin_amdgcn_s_sleep(1); \
    if ((++_sp & 255u) == 0u) { if (xb_ld(&(bar)[XB_TMO])) break; if (_sp > XB_SPIN_CAP) { atomicAdd(&(bar)[XB_TMO], 1u); break; } } } } while (0)
struct XcdBarrier { unsigned* bar; unsigned x; volatile LAS unsigned* st; };
__device__ __forceinline__ XcdBarrier xcd_barrier_post(unsigned* bar, volatile LAS unsigned* st) {
    XcdBarrier b; b.bar = bar; b.x = xb_xcc_id(); b.st = st;
    if (threadIdx.x == 0) (void)xb_add(&bar[XB_XCNT(b.x)], 1u);
    return b;
}
__device__ __forceinline__ void xcd_barrier_complete(unsigned* bar, unsigned x, unsigned& nloc, unsigned& nx) {
    const unsigned G = gridDim.x * gridDim.y * gridDim.z;
    unsigned sum, cnt, mine, sp = 0u;
    for (;;) {
        sum = 0u; cnt = 0u; mine = 0u;
#pragma unroll
        for (unsigned j = 0; j < 16; ++j) { const unsigned c = xb_ld(&bar[XB_XCNT(j)]); sum += c; cnt += (c > 0u) ? 1u : 0u; mine = (j == x) ? c : mine; }
        if (sum == G) break;
        __builtin_amdgcn_s_sleep(1);
        if ((++sp & 255u) == 0u) { if (xb_ld(&bar[XB_TMO])) break; if (sp > XB_SPIN_CAP) { atomicAdd(&bar[XB_TMO], 1u); break; } }
    }
    nloc = mine > 0u ? mine : 1u; nx = cnt > 0u ? cnt : 1u;
}
__device__ __forceinline__ void xcd_barrier(const XcdBarrier& b, const bool t0) {
    asm volatile("s_waitcnt vmcnt(0)" ::: "memory");
    __syncthreads();
    if (t0) {
        unsigned* bar = b.bar;
        __builtin_amdgcn_s_waitcnt(0);
        unsigned nloc = b.st[0], nx = b.st[1];
        if (nloc == 0u) { xcd_barrier_complete(bar, b.x, nloc, nx); b.st[0] = nloc; b.st[1] = nx; }
        const unsigned old = xb_add(&bar[XB_XSUB(b.x)], 1u);
        const unsigned gen = old / nloc;
        if (old + 1u == (gen + 1u) * nloc) {
            __builtin_amdgcn_fence(__ATOMIC_RELEASE, "agent");
            asm volatile("s_waitcnt vmcnt(0)" ::: "memory");
            const unsigned og = xb_add(&bar[XB_TOP], 1u);
            const unsigned tg = og / nx;
            if (og + 1u == (tg + 1u) * nx) xb_add(&bar[XB_TOPGEN], 1u);
            else XB_SPIN(xb_ld(&bar[XB_TOPGEN]) == tg, bar);
            __builtin_amdgcn_fence(__ATOMIC_ACQUIRE, "agent");
            xb_add(&bar[XB_XGEN(b.x)], 1u);
            asm volatile("s_waitcnt vmcnt(0)" ::: "memory");
        } else {
            XB_SPIN(xb_ld(&bar[XB_XGEN(b.x)]) == gen, bar);
            __builtin_amdgcn_fence(__ATOMIC_ACQUIRE, "agent");
            asm volatile("s_waitcnt vmcnt(0)" ::: "memory");
        }
    }
    __syncthreads();
}

namespace pg8 {
constexpr int BM = 256, BK = 64, HALF = 128, HTB = HALF * BK * 2, NXCD = 8, WGM = 8;
#if LDS_FULLLINE
__device__ __forceinline__ int lds_byte(int r, int c) { return r * 128 + ((((c >> 3) ^ (r >> 1)) & 7) << 4) + (c & 7) * 2; }
__device__ __forceinline__ void stage_rc(int b, int& R, int& C) { const int p = b >> 10, L = (b & 1023) >> 4; R = 8 * p + (L >> 3); C = (((L & 7) ^ (R >> 1)) & 7) * 8; }
#else
__device__ __forceinline__ int lds_byte(int r, int c) { const int st = (r >> 4) * 2 + (c >> 5), rr = r & 15, cc = c & 31, ob = rr * 64 + cc * 2; return st * 1024 + (ob ^ (((ob >> 9) & 1) << 5)); }
__device__ __forceinline__ void stage_rc(int b, int& R, int& C) { const int st = b / 1024, sb = b % 1024, swz = sb ^ (((sb >> 9) & 1) << 5); R = (st >> 1) * 16 + swz / 64; C = (st & 1) * 32 + (swz % 64) / 2; }
#endif
__device__ __forceinline__ int perm32(int rho) { const int n = rho >> 4, i = rho & 15; return 8 * (i >> 2) + 4 * n + (i & 3); }

struct Unit { int pm, pn, e, cnt, ord; };

__device__ __forceinline__ bool static_next(int i, int G, int c, int nM, int nN, Unit& u) {
    const int nwg = nM * nN; const long L = (long)i * G + c; if (L >= nwg) return false;
    int wgid = (int)L; { const int q = nwg / NXCD, r = nwg % NXCD, xcd = wgid % NXCD, off = wgid / NXCD; wgid = (xcd < r ? xcd * (q + 1) : r * (q + 1) + (xcd - r) * q) + off; }
    const int nig = WGM * nN, gid = wgid / nig, fm = gid * WGM, gsz = (nM - fm) < WGM ? (nM - fm) : WGM;
    u.pm = fm + ((wgid % nig) % gsz); u.pn = (wgid % nig) / gsz; u.e = 0; u.cnt = 256; return true;
}

template <class P>
__device__ __forceinline__ void gemm_phase(LAS unsigned char* lds, const P& pb, const int tid, const bool skip_epi = false) {
    const int wid = __builtin_amdgcn_readfirstlane(tid >> 6), lane = tid & 63, wr = wid >> 2, wc = wid & 3, fr = lane & 15, fq = lane >> 4;
    const int nt = pb.nt;
    unsigned voffB0[2], voffB1[2];
#pragma unroll
    for (int i = 0; i < 2; ++i) { int R, C; stage_rc(tid * 16 + i * 8192, R, C);
        int r0, r1;
        if constexpr (P::PERM16) { const int w = (R >> 5) & 3, n = (R >> 4) & 1, ii = R & 15; r0 = 64 * w + 16 * (ii >> 2) + 4 * n + (ii & 3); r1 = r0 + 8; }
        else { const int Rb = P::PERM ? ((R & ~31) + perm32(R & 31)) : R; r0 = Rb; r1 = Rb + HALF; }
        voffB0[i] = (unsigned)(r0 * pb.ldb + C) * 2u; voffB1[i] = (unsigned)(r1 * pb.ldb + C) * 2u; }
    const size_t kstep = (size_t)(BK * 2);
    const size_t kstepB = P::FP6B ? (size_t)24576 : kstep;
    unsigned voffB6[3];
#pragma unroll
    for (int i = 0; i < 3; ++i) voffB6[i] = (unsigned)((wid * 3 + i) * 1024 + lane * 16);
    const int brow6 = wc * 32 + fr;
    const int boff16 = (brow6 * 4 + (fq ^ ((0 - (brow6 >> 2)) & 3))) * 16, boff8 = 8192 + (brow6 * 4 + (fq ^ (2 * ((brow6 >> 3) & 1)))) * 8;
    const unsigned ldsw = (unsigned)wid * 1024u;
    const int aoff = lds_byte(wr * 64 + fr, fq * 8), boff = lds_byte(wc * 32 + fr, fq * 8);
    const int aoff1 = lds_byte(wr * 64 + fr, 32 + fq * 8) - aoff, boff1 = lds_byte(wc * 32 + fr, 32 + fq * 8) - boff;
#define PG8_SA(b, h) (((b) * 2 + (h)) * HTB)
#define PG8_SB(b, h) ((4 + (b) * 2 + (h)) * HTB)
#define PG8_STAGE(bufoff, gbase, voff) do { _Pragma("unroll") for (int _i = 0; _i < 2; ++_i) \
        __builtin_amdgcn_global_load_lds((const unsigned*)((const char*)(gbase) + (voff)[_i]), (LAS unsigned*)(lds + (bufoff) + ldsw + _i * 8192), 16, 0, 0); } while (0)
#define PG8_LDA(dst, b, h) do { _Pragma("unroll") for (int m = 0; m < 4; ++m) _Pragma("unroll") for (int k = 0; k < 2; ++k) dst[m][k] = *(const LAS bf16x8*)(lds + PG8_SA(b, h) + aoff + m * 2048 + k * aoff1); } while (0)
#define PG8_STAGEB6(b, gbase) do { _Pragma("unroll") for (int _i = 0; _i < 3; ++_i) \
        __builtin_amdgcn_global_load_lds((const unsigned*)((const char*)(gbase) + voffB6[_i]), (LAS unsigned*)(lds + PG8_SB(b, 0) + (wid >> 2) * HTB + ((wid & 3) * 3 + _i) * 1024), 16, 0, 0); } while (0)
#define PG8_STAGEB(b, gbase) do { if constexpr (P::FP6B) { PG8_STAGEB6(b, gbase); } else { PG8_STAGE(PG8_SB(b, 0), gbase, voffB0); PG8_STAGE(PG8_SB(b, 1), gbase, voffB1); } } while (0)
#define PG8_LDB6(dst, b, h) do { _Pragma("unroll") for (int n = 0; n < 2; ++n) { const u32x4 lo_ = *(const LAS u32x4*)(lds + PG8_SB(b, h) + boff16 + n * 1024); const u32x2 hi_ = *(const LAS u32x2*)(lds + PG8_SB(b, h) + boff8 + n * 512); \
        dst[n] = (v8i){(int)lo_.x, (int)lo_.y, (int)lo_.z, (int)lo_.w, (int)hi_.x, (int)hi_.y, 0, 0}; } } while (0)
#define PG8_LDB(dst, b, h) do { _Pragma("unroll") for (int n = 0; n < 2; ++n) _Pragma("unroll") for (int k = 0; k < 2; ++k) dst[n][k] = *(const LAS bf16x8*)(lds + PG8_SB(b, h) + boff + n * 2048 + k * boff1); } while (0)
#define PG8_CAT(x) __builtin_shufflevector(__builtin_bit_cast(v4i, (x)[0]), __builtin_bit_cast(v4i, (x)[1]), 0, 1, 2, 3, 4, 5, 6, 7)
#define PG8_MMA(ai, bj, At, Bt) do { __builtin_amdgcn_s_setprio(1); \
        if constexpr (P::INT8) { _Pragma("unroll") for (int m = 0; m < 4; ++m) _Pragma("unroll") for (int n = 0; n < 2; ++n) _Pragma("unroll") for (int k = 0; k < 2; ++k) \
            acc[ai][bj][m][n] = __builtin_bit_cast(f32x4, __builtin_amdgcn_mfma_i32_16x16x64_i8(__builtin_bit_cast(v4i, Bt[n][k]), __builtin_bit_cast(v4i, At[m][k]), __builtin_bit_cast(v4i, acc[ai][bj][m][n]), 0, 0, 0)); } \
        else if constexpr (P::FP8) { _Pragma("unroll") for (int m = 0; m < 4; ++m) _Pragma("unroll") for (int n = 0; n < 2; ++n) \
            acc[ai][bj][m][n] = __builtin_amdgcn_mfma_scale_f32_16x16x128_f8f6f4(PG8_CAT(Bt[n]), PG8_CAT(At[m]), acc[ai][bj][m][n], 0, 0, 0, 0, 0, 0); } \
        else { _Pragma("unroll") for (int m = 0; m < 4; ++m) _Pragma("unroll") for (int n = 0; n < 2; ++n) _Pragma("unroll") for (int k = 0; k < 2; ++k) \
            acc[ai][bj][m][n] = __builtin_amdgcn_mfma_f32_16x16x32_bf16(Bt[n][k], At[m][k], acc[ai][bj][m][n], 0, 0, 0); } \
        __builtin_amdgcn_s_setprio(0); } while (0)
#define PG8_MMA6(ai, bj, At, B6) do { __builtin_amdgcn_s_setprio(1); \
        _Pragma("unroll") for (int m = 0; m < 4; ++m) _Pragma("unroll") for (int n = 0; n < 2; ++n) \
            acc[ai][bj][m][n] = __builtin_amdgcn_mfma_scale_f32_16x16x128_f8f6f4(B6[n], PG8_CAT(At[m]), acc[ai][bj][m][n], 2, 0, 0, 0, 0, 0); \
        __builtin_amdgcn_s_setprio(0); } while (0)
#define PG8_WAIT_V(n) asm volatile("s_waitcnt vmcnt(" #n ")" ::: "memory")
#define PG8_WAIT_VK do { if constexpr (P::FP6B) PG8_WAIT_V(7); else PG8_WAIT_V(8); } while (0)
#define PG8_MMAB(ai) do { if constexpr (P::FP6B) { PG8_MMA6(ai, 0, At, B60); PG8_MMA6(ai, 1, At, B61); } else { PG8_MMA(ai, 0, At, B0); PG8_MMA(ai, 1, At, B1); } } while (0)
#define PG8_WAIT_L(n) asm volatile("s_waitcnt lgkmcnt(" #n ")" ::: "memory")
#define PG8_BAR __builtin_amdgcn_s_barrier()
#define PG8_SCHED __builtin_amdgcn_sched_barrier(0)
    Unit cur, nxt; int ui = 0;
    if (!pb.next(0, cur)) return;
    f32x4 acc[2][2][4][2];
#pragma unroll
    for (int a = 0; a < 2; ++a)
#pragma unroll
        for (int b = 0; b < 2; ++b)
#pragma unroll
            for (int m = 0; m < 4; ++m)
#pragma unroll
                for (int n = 0; n < 2; ++n) acc[a][b][m][n] = (f32x4){0.f, 0.f, 0.f, 0.f};
    bf16x8 At[4][2], B0[2][2], B1[2][2]; v8i B60[2], B61[2];
    unsigned vAc[2][2], vAn[2][2];
    if constexpr (P::META) { if (wid == 0) pb.meta(cur, lane); }
    pb.a_voff(cur, vAc, tid);
    const char* cA = pb.a_ptr(cur); const char* cB = pb.b_ptr(cur);
    PG8_STAGEB(0, cB); PG8_STAGE(PG8_SA(0, 0), cA, vAc[0]); PG8_STAGE(PG8_SA(0, 1), cA, vAc[1]);
    if (wr == 1) PG8_BAR;
    PG8_WAIT_V(2); PG8_BAR;
    PG8_STAGEB(1, cB + kstepB); PG8_STAGE(PG8_SA(1, 0), cA + kstep, vAc[0]);
    if constexpr (P::FP6B) PG8_WAIT_V(5); else PG8_WAIT_V(6);
    PG8_BAR;
    for (;;) {
        const bool has_next = pb.next(ui + 1, nxt);
        const char* nA = has_next ? pb.a_ptr(nxt) : cA; const char* nB = has_next ? pb.b_ptr(nxt) : cB;
        if constexpr (P::META) { if (has_next && wid == 0) pb.meta(nxt, lane_id_now()); }
        if (has_next) { if constexpr (!P::META) pb.a_voff(nxt, vAn, tid); }
        else {
#pragma unroll
            for (int h = 0; h < 2; ++h)
#pragma unroll
                for (int i = 0; i < 2; ++i) vAn[h][i] = vAc[h][i]; }
        for (int t = 0; t < nt; t += 2) {
            const bool last = (t == nt - 2);
            const char* a1 = cA + (size_t)(t + 1) * kstep;
            const char* a2 = last ? nA : cA + (size_t)(t + 2) * kstep; const char* b2 = last ? nB : cB + (size_t)(t + 2) * kstepB;
            const char* a3 = a2 + kstep; const char* b3 = b2 + kstepB;
            if (P::MID >= 0 && t == P::MID) pb.mid(acc, cur, wr, wc, fr, fq);
            if constexpr (P::GATHER) { if (last && has_next) pb.a_voff_lds(nxt, vAn, wid * 64 + lane_id_now()); }
            if constexpr (P::FP6B) { PG8_LDB6(B60, 0, 0); PG8_LDB6(B61, 0, 1); } else { PG8_LDB(B0, 0, 0); PG8_LDB(B1, 0, 1); } PG8_SCHED; PG8_LDA(At, 0, 0); PG8_STAGE(PG8_SA(1, 1), a1, vAc[1]);
            if (last) {
#pragma unroll
                for (int h = 0; h < 2; ++h)
#pragma unroll
                    for (int i = 0; i < 2; ++i) vAc[h][i] = vAn[h][i]; }
            PG8_WAIT_VK; PG8_WAIT_L(0); PG8_BAR; PG8_MMAB(0); PG8_BAR; PG8_SCHED;
            PG8_LDA(At, 0, 1); PG8_STAGEB(0, b2); PG8_STAGE(PG8_SA(0, 0), a2, vAc[0]);
            PG8_WAIT_VK; PG8_WAIT_L(0); PG8_BAR; PG8_MMAB(1); PG8_BAR; PG8_SCHED;
            if constexpr (P::FP6B) { PG8_LDB6(B60, 1, 0); PG8_LDB6(B61, 1, 1); } else { PG8_LDB(B0, 1, 0); PG8_LDB(B1, 1, 1); } PG8_SCHED; PG8_LDA(At, 1, 0); PG8_STAGE(PG8_SA(0, 1), a2, vAc[1]);
            PG8_WAIT_VK; PG8_WAIT_L(0); PG8_BAR; PG8_MMAB(0); PG8_BAR; PG8_SCHED;
            PG8_LDA(At, 1, 1); PG8_STAGEB(1, b3); PG8_STAGE(PG8_SA(1, 0), a3, vAc[0]);
            PG8_WAIT_VK; PG8_WAIT_L(0); PG8_BAR; PG8_MMAB(1); PG8_BAR; PG8_SCHED;
        }
        if (wr == 0) PG8_BAR;
        if constexpr (!P::AFTER_DRAIN) { if (!skip_epi) pb.epi(acc, cur, wr, wc, fr, fq); }
        if (!has_next) break;
#pragma unroll
        for (int a = 0; a < 2; ++a)
#pragma unroll
            for (int b = 0; b < 2; ++b)
#pragma unroll
                for (int m = 0; m < 4; ++m)
#pragma unroll
                    for (int n = 0; n < 2; ++n) acc[a][b][m][n] = (f32x4){0.f, 0.f, 0.f, 0.f};
        cur = nxt; cA = nA; cB = nB; ++ui;
        if (wr == 1) PG8_BAR;
    }
    PG8_WAIT_V(0);
    PG8_BAR;
    if constexpr (P::AFTER_DRAIN) { if (!skip_epi) pb.epi(acc, cur, wr, wc, fr, fq); }
#undef PG8_SA
#undef PG8_SB
#undef PG8_STAGE
#undef PG8_STAGEB
#undef PG8_STAGEB6
#undef PG8_LDB6
#undef PG8_MMA6
#undef PG8_MMAB
#undef PG8_WAIT_VK
#undef PG8_LDA
#undef PG8_LDB
#undef PG8_MMA
#undef PG8_CAT
#undef PG8_WAIT_V
#undef PG8_WAIT_L
#undef PG8_BAR
#undef PG8_SCHED
}
}
using pg8::Unit;
typedef f32x4 AccT[2][2][4][2];

struct Frame {
    LAS unsigned char* lds;
    int tid, lane, wave, G, gw, ngw;
    const float* in[26];
    float* out;
    unsigned char* ws;
};
template <class T> __device__ __forceinline__ T* wsp(const Frame& F, size_t off) { return (T*)(F.ws + off); }

struct DenseBase {
    const bf16* A; const bf16* Bt; int lda, ldb, nM, nN, G, c, nt;
    __device__ __forceinline__ bool next(int i, Unit& u) const { u.ord = i; return pg8::static_next(i, G, c, nM, nN, u); }
    __device__ __forceinline__ const char* a_ptr(const Unit& u) const { return (const char*)A + (size_t)u.pm * 256 * lda * 2; }
    __device__ __forceinline__ const char* b_ptr(const Unit& u) const { return (const char*)Bt + (size_t)u.pn * 256 * ldb * 2; }
    __device__ __forceinline__ void a_voff(const Unit&, unsigned (&v)[2][2], int tid_) const {
        int tz = tid_; asm volatile("" : "+v"(tz));
#pragma unroll
        for (int i = 0; i < 2; ++i) { int R, C; pg8::stage_rc(tz * 16 + i * 8192, R, C);
#pragma unroll
            for (int h = 0; h < 2; ++h) v[h][i] = (unsigned)((h * 128 + R) * lda + C) * 2u; }
    }
    __device__ __forceinline__ void mid(AccT&, const Unit&, int, int, int, int) const {}
};
struct ProbInProj : DenseBase {
    static constexpr bool PERM = true, FP8 = false, AFTER_DRAIN = false, META = false, GATHER = false, PERM16 = false, INT8 = true, FP6B = false; static constexpr int MID = -1;
    const float* rowsc; const float* sw; bf16* O; bf16* UB;
    __device__ __forceinline__ void epi(const AccT& acc, const Unit& u, int wr, int wc, int fr, int fq) const {
        int row0 = u.pm * 256 + wr * 64 + fr, col0 = u.pn * 256 + wc * 32 + 8 * fq; asm volatile("" : "+v"(row0), "+v"(col0));
        const bool ucols = u.pn < 2;
        f32x4 sv[2][2];
#pragma unroll
        for (int bj = 0; bj < 2; ++bj)
#pragma unroll
            for (int n = 0; n < 2; ++n) sv[bj][n] = *(const f32x4*)(sw + col0 + bj * 128 + 4 * n);
#pragma unroll
        for (int ai = 0; ai < 2; ++ai)
#pragma unroll
            for (int m = 0; m < 4; ++m) { const int row = row0 + ai * 128 + m * 16; const float rs = rowsc[(unsigned)row];
#pragma unroll
                for (int bj = 0; bj < 2; ++bj) { const v4i i0 = __builtin_bit_cast(v4i, acc[ai][bj][m][0]), i1 = __builtin_bit_cast(v4i, acc[ai][bj][m][1]);
                    const f32x4 v0 = (f32x4){(float)i0[0], (float)i0[1], (float)i0[2], (float)i0[3]} * sv[bj][0] * rs, v1 = (f32x4){(float)i1[0], (float)i1[1], (float)i1[2], (float)i1[3]} * sv[bj][1] * rs;
                    u32x4 w; w.x = pk2(v0[0], v0[1]); w.y = pk2(v0[2], v0[3]); w.z = pk2(v1[0], v1[1]); w.w = pk2(v1[2], v1[3]);
                    const int col = col0 + bj * 128;
                    if (ucols) *(u32x4*)(UB + (unsigned)(((row >> 5) * NG + (col >> 4)) * UK + (row & 31) * 16 + (col & 15))) = w;
                    else *(u32x4*)(O + (unsigned)(row * INW + col)) = w; } }
    }
};

struct ProbGlu : DenseBase {
    static constexpr bool PERM = true, FP8 = false, AFTER_DRAIN = false, META = false, GATHER = false, PERM16 = false, INT8 = false, FP6B = false; static constexpr int MID = -1;
    const bf16* Z; const float* bias; bf16* O; float* ssqp;
    __device__ __forceinline__ void epi(const AccT& acc, const Unit& u, int wr, int wc, int fr, int fq) const {
        int row0 = u.pm * 256 + wr * 64 + fr, col0 = u.pn * 256 + wc * 32 + 8 * fq; asm volatile("" : "+v"(row0), "+v"(col0));
        f32x4 bv[2][2];
#pragma unroll
        for (int bj = 0; bj < 2; ++bj)
#pragma unroll
            for (int n = 0; n < 2; ++n) bv[bj][n] = *(const f32x4*)(bias + col0 + bj * 128 + 4 * n);
#pragma unroll
        for (int ai = 0; ai < 2; ++ai)
#pragma unroll
            for (int m = 0; m < 4; ++m) { const int row = row0 + ai * 128 + m * 16; float ss = 0.f;
#pragma unroll
                for (int bj = 0; bj < 2; ++bj) {
                    const u32x4 zz = *(const u32x4*)(Z + (unsigned)(row * SSMW + col0 + bj * 128));
                    const f32x4 a0 = acc[ai][bj][m][0] + bv[bj][0], a1 = acc[ai][bj][m][1] + bv[bj][1];
                    float o[8];
                    o[0] = bflo(zz.x) * fast_sigmoid(a0[0]); o[1] = bfhi(zz.x) * fast_sigmoid(a0[1]); o[2] = bflo(zz.y) * fast_sigmoid(a0[2]); o[3] = bfhi(zz.y) * fast_sigmoid(a0[3]);
                    o[4] = bflo(zz.z) * fast_sigmoid(a1[0]); o[5] = bfhi(zz.z) * fast_sigmoid(a1[1]); o[6] = bflo(zz.w) * fast_sigmoid(a1[2]); o[7] = bfhi(zz.w) * fast_sigmoid(a1[3]);
                    if (DBG_SKIP & 2) {
#pragma unroll
                        for (int j = 0; j < 8; ++j) o[j] = 0.f; }
#pragma unroll
                    for (int j = 0; j < 8; ++j) ss += o[j] * o[j];
                    u32x4 w; w.x = pk2(o[0], o[1]); w.y = pk2(o[2], o[3]); w.z = pk2(o[4], o[5]); w.w = pk2(o[6], o[7]);
                    *(u32x4*)(O + (unsigned)(row * DM + col0 + bj * 128)) = w; }
                { const int ln = fq * 16 + fr; ss += shx(ss, 16, ln); ss += shx(ss, 32, ln); }
                if (fq == 0) ssqp[(unsigned)(row * 8 + u.pn * 4 + wc)] = ss; }
    }
};
struct ProbOutProj : DenseBase {
    static constexpr bool PERM = true, FP8 = false, AFTER_DRAIN = false, META = false, GATHER = false, PERM16 = false, INT8 = false, FP6B = false; static constexpr int MID = 8;
    const bf16* xres; bf16* X1b; unsigned char* X1q; const LAS float* rsT;
    __device__ __forceinline__ void mid(AccT& acc, const Unit& u, int wr, int wc, int fr, int fq) const {
        const LAS float* t = rsT + (u.ord & 1) * 256 + wr * 64 + fr;
#pragma unroll
        for (int ai = 0; ai < 2; ++ai)
#pragma unroll
            for (int m = 0; m < 4; ++m) { const float rs = t[ai * 128 + m * 16];
#pragma unroll
                for (int bj = 0; bj < 2; ++bj)
#pragma unroll
                    for (int n = 0; n < 2; ++n) acc[ai][bj][m][n] *= rs; }
    }
    __device__ __forceinline__ void epi(const AccT& acc, const Unit& u, int wr, int wc, int fr, int fq) const {
        int row0 = u.pm * 256 + wr * 64 + fr, col0 = u.pn * 256 + wc * 32 + 8 * fq; asm volatile("" : "+v"(row0), "+v"(col0));
#pragma unroll
        for (int ai = 0; ai < 2; ++ai)
#pragma unroll
            for (int m = 0; m < 4; ++m) { const unsigned off = (unsigned)((row0 + ai * 128 + m * 16) * DM + col0);
#pragma unroll
                for (int bj = 0; bj < 2; ++bj) { const u32x4 xr = *(const u32x4*)(xres + off + bj * 128); const f32x4 a0 = acc[ai][bj][m][0], a1 = acc[ai][bj][m][1];
                    const float v0 = bflo(xr.x) + a0[0], v1 = bfhi(xr.x) + a0[1], v2 = bflo(xr.y) + a0[2], v3 = bfhi(xr.y) + a0[3];
                    const float v4 = bflo(xr.z) + a1[0], v5 = bfhi(xr.z) + a1[1], v6 = bflo(xr.w) + a1[2], v7 = bfhi(xr.w) + a1[3];
                    u32x4 w; w.x = pk2(v0, v1); w.y = pk2(v2, v3); w.z = pk2(v4, v5); w.w = pk2(v6, v7); *(u32x4*)(X1b + off + bj * 128) = w;
                    u32x2 q; q.x = pk4_fp8(v0, v1, v2, v3); q.y = pk4_fp8(v4, v5, v6, v7); *(u32x2*)(X1q + off + bj * 128) = q; }
                if (m == 3) asm volatile("" ::: "memory"); }
    }
};
struct ProbSState {
    static constexpr bool PERM = false, FP8 = false, AFTER_DRAIN = true, META = false, GATHER = false, PERM16 = false, INT8 = false, FP6B = false; static constexpr int MID = -1;
    const bf16* UB; const bf16* PZ; LAS float* Sl; int c, nt, ldb;
    __device__ __forceinline__ bool next(int i, Unit& u) const { if (i > 0 || c >= 128) return false; const int x = c & 7, j = c >> 3;
        u.pm = j & 3; u.pn = x * 4 + (j >> 2); u.e = 0; u.cnt = 256; u.ord = 0; return true; }
    __device__ __forceinline__ const char* a_ptr(const Unit& u) const { return (const char*)UB + ((size_t)u.pm * 256 * ULD + (size_t)u.pn * UK) * 2; }
    __device__ __forceinline__ const char* b_ptr(const Unit& u) const { return (const char*)PZ + ((size_t)(u.pn >> 1) * 256 * 1280 + (size_t)(u.pn & 1) * UK) * 2; }
    __device__ __forceinline__ void a_voff(const Unit&, unsigned (&v)[2][2], int tid_) const {
        int tz = tid_; asm volatile("" : "+v"(tz));
#pragma unroll
        for (int i = 0; i < 2; ++i) { int R, C; pg8::stage_rc(tz * 16 + i * 8192, R, C);
#pragma unroll
            for (int h = 0; h < 2; ++h) v[h][i] = (unsigned)((h * 128 + R) * ULD + C) * 2u; }
    }
    __device__ __forceinline__ void mid(AccT&, const Unit&, int, int, int, int) const {}
    __device__ __forceinline__ void epi(const AccT& acc, const Unit& u, int wr, int wc, int fr, int fq) const {
        const int row0 = wr * 64 + fr, comp0 = wc * 32 + 4 * fq;
#pragma unroll
        for (int ai = 0; ai < 2; ++ai)
#pragma unroll
            for (int m = 0; m < 4; ++m) { const int ch = row0 + ai * 128 + m * 16;
#pragma unroll
                for (int bj = 0; bj < 2; ++bj)
#pragma unroll
                    for (int n = 0; n < 2; ++n) if (bj == (u.pn & 1)) *(LAS f32x4*)(Sl + ch * SPITCH + comp0 + n * 16) = acc[ai][bj][m][n]; }
    }
};
struct ProbSsmOut {
    static constexpr bool PERM = true, FP8 = false, AFTER_DRAIN = false, META = false, GATHER = false, PERM16 = false, INT8 = false, FP6B = false; static constexpr int MID = -1;
    const bf16* UB; const bf16* TZ; const float* dsk; bf16* Z; int G, c, nt, ldb;
    __device__ __forceinline__ bool next(int i, Unit& u) const { int L = i * G + c; if (L >= NG * 8) return false;
        if (G == 256) { const int x = c & 7, j = c >> 3; L = (x * 4 + (j >> 3)) * 8 + (j & 7); }
        u.e = L >> 3; u.pm = (L & 7) >> 1; u.pn = L & 1; u.cnt = 256; u.ord = i; return true; }
    __device__ __forceinline__ const char* a_ptr(const Unit& u) const { return (const char*)UB + ((size_t)u.pm * 256 * ULD + (size_t)u.e * UK) * 2; }
    __device__ __forceinline__ const char* b_ptr(const Unit& u) const { return (const char*)TZ + ((size_t)u.e * 512 + (size_t)u.pn * 256) * UK * 2; }
    __device__ __forceinline__ void a_voff(const Unit&, unsigned (&v)[2][2], int tid_) const {
        int tz = tid_; asm volatile("" : "+v"(tz));
#pragma unroll
        for (int i = 0; i < 2; ++i) { int R, C; pg8::stage_rc(tz * 16 + i * 8192, R, C);
#pragma unroll
            for (int h = 0; h < 2; ++h) v[h][i] = (unsigned)((h * 128 + R) * ULD + C) * 2u; }
    }
    __device__ __forceinline__ void mid(AccT&, const Unit&, int, int, int, int) const {}
    __device__ __forceinline__ void epi(const AccT& acc, const Unit& u, int wr, int wc, int fr, int fq) const {
        int row0 = u.pm * 256 + wr * 64 + fr, n00 = u.pn * 256 + wc * 32 + 8 * fq; asm volatile("" : "+v"(row0), "+v"(n00));
        const int h0 = n00 & 15;
        const f32x4 d0 = *(const f32x4*)(dsk + u.e * 16 + h0), d1 = *(const f32x4*)(dsk + u.e * 16 + h0 + 4);
#pragma unroll
        for (int ai = 0; ai < 2; ++ai)
#pragma unroll
            for (int m = 0; m < 4; ++m) { const int col = row0 + ai * 128 + m * 16;
#pragma unroll
                for (int bj = 0; bj < 2; ++bj) { const int n0 = n00 + bj * 128;
                    const u32x4 uu = *(const u32x4*)(UB + (unsigned)((col * NG + u.e) * UK + n0));
                    float y[8];
                    y[0] = acc[ai][bj][m][0][0] + d0[0] * bflo(uu.x); y[1] = acc[ai][bj][m][0][1] + d0[1] * bfhi(uu.x); y[2] = acc[ai][bj][m][0][2] + d0[2] * bflo(uu.y); y[3] = acc[ai][bj][m][0][3] + d0[3] * bfhi(uu.y);
                    y[4] = acc[ai][bj][m][1][0] + d1[0] * bflo(uu.z); y[5] = acc[ai][bj][m][1][1] + d1[1] * bfhi(uu.z); y[6] = acc[ai][bj][m][1][2] + d1[2] * bflo(uu.w); y[7] = acc[ai][bj][m][1][3] + d1[3] * bfhi(uu.w);
#pragma unroll
                    for (int j = 0; j < 8; ++j) { const float yy = y[j]; y[j] = yy * fast_sigmoid(1.5957691216f * (yy + 0.044715f * yy * yy * yy)); }
                    u32x4 w; w.x = pk2(y[0], y[1]); w.y = pk2(y[2], y[3]); w.z = pk2(y[4], y[5]); w.w = pk2(y[6], y[7]);
                    *(u32x4*)(Z + (unsigned)((col * CH + (n0 >> 4)) * SSMW + u.e * 16 + h0)) = w; }
                if (m == 3) asm volatile("" ::: "memory"); }
    }
};
struct GroupedBase {
    const LAS int* ecnt; const LAS int* mbpre; int NT, G, c, nt, ldb;
    LAS unsigned char* mt;
    __device__ __forceinline__ LAS unsigned char* slot(const Unit& u) const { const int q = (u.ord * 21846) >> 16; return mt + (u.ord - 3 * q) * 3072; }
    __device__ __forceinline__ bool next(int i, Unit& u) const {
        u.ord = i;
        const int TM = __builtin_amdgcn_readfirstlane(mbpre[NE]); int mbg;
        if (G == 256) {
            const int x = c & 7, j = c >> 3, a = 32 / NT; mbg = (i * 8 + x) * a + j / NT; u.pn = j % NT; if (mbg >= TM) return false;
        } else { const int L = i * G + c; if (L >= TM * NT) return false; mbg = L / NT; u.pn = L - mbg * NT; }
        u.pm = mbg;
        int e = 0;
        for (int j = 1; j < NE; ++j) e += (mbpre[j] <= mbg) ? 1 : 0;
        const int mb = mbg - mbpre[e]; const int rem = ecnt[e] - mb * 256;
        u.e = __builtin_amdgcn_readfirstlane(e); u.cnt = __builtin_amdgcn_readfirstlane(rem < 256 ? rem : 256);
        u.pm = __builtin_amdgcn_readfirstlane(u.pm); u.pn = __builtin_amdgcn_readfirstlane(u.pn);
        return true;
    }
    __device__ __forceinline__ void mid(AccT&, const Unit&, int, int, int, int) const {}
};
struct ProbGateUp : GroupedBase {
    static constexpr bool PERM = true, FP8 = true, AFTER_DRAIN = false, META = true, GATHER = true, PERM16 = false, INT8 = false, FP6B = (GU_FP6 != 0); static constexpr int MID = -1;
    const unsigned char* X; const unsigned char* Wt; const int* rowl; const float* rowr; const float* bgu; unsigned char* H;
    __device__ __forceinline__ const char* a_ptr(const Unit&) const { return (const char*)X; }
    __device__ __forceinline__ const char* b_ptr(const Unit& u) const { return GU_FP6 ? (const char*)Wt + (size_t)((u.e * 8 + u.pn) * 8) * 24576 : (const char*)Wt + ((size_t)u.e * 2048 + (size_t)u.pn * 256) * DM; }
    __device__ __forceinline__ void a_voff(const Unit& u, unsigned (&v)[2][2], int tid_) const {
        const int mb = __builtin_amdgcn_readfirstlane(u.pm - mbpre[u.e]); const int* rl = rowl + (size_t)u.e * ROWCAP + mb * 256;
        int tz = tid_; asm volatile("" : "+v"(tz));
#pragma unroll
        for (int i = 0; i < 2; ++i) { int R, C; pg8::stage_rc(tz * 16 + i * 8192, R, C);
#pragma unroll
            for (int h = 0; h < 2; ++h) { int r = h * 128 + R; r = r < u.cnt ? r : 0; const int tok = rl[(unsigned)r] >> 2; v[h][i] = (unsigned)(tok * DM + C * 2); } }
    }
    __device__ __forceinline__ void a_voff_lds(const Unit& u, unsigned (&v)[2][2], int tid_) const {
        const LAS int* rl = (const LAS int*)(slot(u) + 2048);
        int tz = tid_; asm volatile("" : "+v"(tz));
#pragma unroll
        for (int i = 0; i < 2; ++i) { int R, C; pg8::stage_rc(tz * 16 + i * 8192, R, C);
#pragma unroll
            for (int h = 0; h < 2; ++h) { int r = h * 128 + R; r = r < u.cnt ? r : 0; const int tok = rl[r] >> 2; v[h][i] = (unsigned)(tok * DM + C * 2); } }
    }
    __device__ __forceinline__ void meta(const Unit& u, int lane) const {
        const int mb = __builtin_amdgcn_readfirstlane(u.pm - mbpre[u.e]); LAS unsigned char* t = slot(u); const size_t ro = (size_t)u.e * ROWCAP + mb * 256 + lane * 4;
        __builtin_amdgcn_global_load_lds((const unsigned*)(rowr + ro), (LAS unsigned*)t, 16, 0, 0);
        const float* bsrc = bgu + (size_t)u.e * 2048 + u.pn * 128 + (lane < 32 ? lane * 4 : 1024 + (lane - 32) * 4);
        __builtin_amdgcn_global_load_lds((const unsigned*)bsrc, (LAS unsigned*)(t + 1024), 16, 0, 0);
        __builtin_amdgcn_global_load_lds((const unsigned*)(rowl + ro), (LAS unsigned*)(t + 2048), 16, 0, 0);
    }
    __device__ __forceinline__ void epi(const AccT& acc, const Unit& u, int wr, int wc, int fr, int fq) const {
        const LAS float* rr_ = (const LAS float*)slot(u); const LAS float* bg = rr_ + 256 + wc * 32 + 8 * fq;
        int r0 = wr * 64 + fr, col0 = u.pn * 128 + wc * 32 + 8 * fq; asm volatile("" : "+v"(r0), "+v"(col0));
        const f32x4 bg0 = *(const LAS f32x4*)(bg), bg1 = *(const LAS f32x4*)(bg + 4), bu0 = *(const LAS f32x4*)(bg + 128) + 1.0f, bu1 = *(const LAS f32x4*)(bg + 132) + 1.0f;
#pragma unroll
        for (int ai = 0; ai < 2; ++ai)
#pragma unroll
            for (int mp = 0; mp < 2; ++mp) { u32x2 w[2]; float rsv[2];
#pragma unroll
                for (int mm = 0; mm < 2; ++mm) { const int r = r0 + ai * 128 + (2 * mp + mm) * 16; rsv[mm] = rr_[r < u.cnt ? r : 0]; }
#pragma unroll
                for (int mm = 0; mm < 2; ++mm) { const int m = 2 * mp + mm; const float rs = rsv[mm] * W8_INV;
                    float o[8];
#pragma unroll
                    for (int n = 0; n < 2; ++n) { const f32x4 gb = n ? bg1 : bg0, ub = n ? bu1 : bu0;
#pragma unroll
                        for (int j = 0; j < 4; ++j) { float gt = acc[ai][0][m][n][j] * rs + gb[j], up = acc[ai][1][m][n][j] * rs + ub[j];
                            gt = fminf(gt, 7.0f); up = __builtin_amdgcn_fmed3f(up, -6.0f, 8.0f);
                            o[n * 4 + j] = gt * __builtin_amdgcn_rcpf(1.0f + __builtin_amdgcn_exp2f(gt * (-1.702f * 1.44269504f))) * up; } }
                    w[mm].x = pk4_fp8(o[0], o[1], o[2], o[3]); w[mm].y = pk4_fp8(o[4], o[5], o[6], o[7]); asm volatile("" : "+v"(w[mm].x), "+v"(w[mm].y)); }
                const auto sx = __builtin_amdgcn_permlane16_swap(w[0].x, w[1].x, false, false), sy = __builtin_amdgcn_permlane16_swap(w[0].y, w[1].y, false, false);
                u32x4 q; q.x = sx[0]; q.y = sy[0]; q.z = sx[1]; q.w = sy[1];
                const int r = r0 + ai * 128 + mp * 32 + (fq & 1) * 16;
                *(u32x4*)(H + (unsigned)((u.pm * 256 + r) * DM + col0 - 8 * (fq & 1))) = q;
                asm volatile("" ::: "memory"); }
    }
};
struct ProbDown : GroupedBase {
    static constexpr bool PERM = true, FP8 = true, AFTER_DRAIN = false, META = true, GATHER = false, PERM16 = true, INT8 = false, FP6B = false; static constexpr int MID = -1;
    const unsigned char* Hm; const unsigned char* Wt; const int* rowl; const float* gate; const float* bdn; unsigned char* Y;
    __device__ __forceinline__ const char* a_ptr(const Unit& u) const { return (const char*)Hm + (size_t)u.pm * 256 * DM; }
    __device__ __forceinline__ const char* b_ptr(const Unit& u) const { return (const char*)Wt + ((size_t)u.e * 1024 + (size_t)u.pn * 256) * DM; }
    __device__ __forceinline__ void a_voff(const Unit&, unsigned (&v)[2][2], int tid_) const {
        int tz = tid_; asm volatile("" : "+v"(tz));
#pragma unroll
        for (int i = 0; i < 2; ++i) { int R, C; pg8::stage_rc(tz * 16 + i * 8192, R, C);
#pragma unroll
            for (int h = 0; h < 2; ++h) v[h][i] = (unsigned)((h * 128 + R) * DM + C * 2); }
    }
    __device__ __forceinline__ void a_voff_lds(const Unit& u, unsigned (&v)[2][2], int tid_) const { a_voff(u, v, tid_); }
    __device__ __forceinline__ void meta(const Unit& u, int lane) const {
        const int mb = __builtin_amdgcn_readfirstlane(u.pm - mbpre[u.e]); LAS unsigned char* t = slot(u); const size_t ro = (size_t)u.e * ROWCAP + mb * 256 + lane * 4;
        __builtin_amdgcn_global_load_lds((const unsigned*)(gate + ro), (LAS unsigned*)t, 16, 0, 0);
        __builtin_amdgcn_global_load_lds((const unsigned*)(bdn + (size_t)u.e * DM + u.pn * 256 + lane * 4), (LAS unsigned*)(t + 1024), 16, 0, 0);
        __builtin_amdgcn_global_load_lds((const unsigned*)(rowl + ro), (LAS unsigned*)(t + 2048), 16, 0, 0);
    }
    __device__ __forceinline__ void epi(const AccT& acc, const Unit& u, int wr, int wc, int fr, int fq) const {
        const LAS float* rg = (const LAS float*)slot(u); const LAS float* bb = rg + 256 + wc * 64 + 16 * fq; const LAS int* rl = (const LAS int*)(rg + 512);
        int r0 = wr * 64 + fr, col0 = u.pn * 256 + wc * 64 + 16 * fq; asm volatile("" : "+v"(r0), "+v"(col0));
        f32x4 bv[2][2];
#pragma unroll
        for (int bj = 0; bj < 2; ++bj)
#pragma unroll
            for (int n = 0; n < 2; ++n) bv[bj][n] = *(const LAS f32x4*)(bb + 8 * bj + 4 * n);
#pragma unroll
        for (int ai = 0; ai < 2; ++ai)
#pragma unroll
            for (int m = 0; m < 4; ++m) { const int r = r0 + ai * 128 + m * 16;
                if (r < u.cnt) { const int tokk = rl[r]; const float gt = rg[r] * Y8_SCALE;
                    u32x4 w;
#pragma unroll
                    for (int bj = 0; bj < 2; ++bj)
#pragma unroll
                        for (int n = 0; n < 2; ++n) { const f32x4 v = (acc[ai][bj][m][n] * W8_INV + bv[bj][n]) * gt; w[2 * bj + n] = pk4_fp8(v[0], v[1], v[2], v[3]); }
                    *(u32x4*)(Y + (unsigned)(tokk * DM + col0)) = w; } }
    }
};

struct TDesc { const float* src; const float* gk; unsigned char* dst; int ldn, pitch, fp8, valid; };
__device__ __forceinline__ TDesc tdesc_make(const float* W, int ldn, int k0, int n0, const float* gk, void* WT, int ldk, int drow0, int fp8) {
    TDesc d; d.src = W + (size_t)k0 * ldn + n0; d.gk = gk ? gk + k0 : nullptr; d.ldn = ldn; d.fp8 = fp8; d.valid = 1;
    d.pitch = fp8 ? ldk : ldk * 2; d.dst = (unsigned char*)WT + (size_t)drow0 * d.pitch + (fp8 ? k0 : k0 * 2); return d;
}
__device__ __forceinline__ TDesc tdesc_decode(const Frame& F, int it) {
    constexpr int I_IN = 16 * 48, I_GLU = 8 * 16, I_OUT = 16 * 32, I_GU = NE * 16 * 64, I_DN = NE * 16 * 32, I_L = I_IN + I_GLU + I_OUT + I_GU + I_DN;
    const int l = it / I_L; int r = it - l * I_L;
    unsigned char* wl = F.ws + WS_W + (size_t)l * WL_STRIDE;
    if (r < I_IN) { const int kb = r / 48, nb = r % 48;
        TDesc d = tdesc_make(F.in[2] + (size_t)l * DM * INW, INW, kb * 64, nb * 32, F.in[1] + l * DM, wl + WL_IN, DM, nb * 32, 0);
        d.valid = 0;
        return d; } r -= I_IN;
    if (r < I_GLU) { const int kb = r / 16, nb = r % 16; return tdesc_make(F.in[11] + (size_t)l * SSMW * SSMW, SSMW, kb * 64, nb * 32, nullptr, wl + WL_GLU, SSMW, nb * 32, 0); } r -= I_GLU;
    if (r < I_OUT) { const int kb = r / 32, nb = r % 32; return tdesc_make(F.in[17] + (size_t)l * DM * DM, DM, kb * 64, nb * 32, F.in[16] + l * DM, wl + WL_OUT, DM, nb * 32, 0); } r -= I_OUT;
    if (r < I_GU) { const int e = r / 1024, q = r % 1024, kb = q / 64, nb = q % 64, n0 = nb * 32;
        const int drow0 = ((n0 & 1023) >> 7) * 256 + (n0 >> 10) * 128 + (n0 & 127);
        TDesc d = tdesc_make(F.in[21] + ((size_t)l * NE + e) * DM * 2048, 2048, kb * 64, n0, F.in[18] + l * DM, wl + WL_GU + (size_t)e * 2048 * DM, DM, drow0, 1);
        if (GU_FP6) d.valid = 0;
        return d; } r -= I_GU;
    { const int e = r / 512, q = r % 512, kb = q / 32, nb = q % 32;
        return tdesc_make(F.in[23] + ((size_t)l * NE + e) * DM * DM, DM, kb * 64, nb * 32, nullptr, wl + WL_DN + (size_t)e * DM * DM, DM, nb * 32, 1); }
}
__device__ __forceinline__ void tdesc_load(const TDesc& d, f32x4 (&v)[8], int lane) {
    const int rr = lane >> 3, c4 = (lane & 7) * 4;
    if (d.valid) {
#pragma unroll
        for (int i = 0; i < 8; ++i) v[i] = *(const f32x4*)(d.src + (size_t)(i * 8 + rr) * d.ldn + c4); }
}
__device__ __forceinline__ void tdesc_finish(const TDesc& d, const f32x4 (&v)[8], LAS float* scr, int lane) {
    if (!d.valid) return;
    { const int rr = lane >> 3, c4 = (lane & 7) * 4; const float sc = d.fp8 ? W8_SCALE : 1.0f;
#pragma unroll
      for (int i = 0; i < 8; ++i) { const int kk = i * 8 + rr; const float g = d.gk ? d.gk[kk] * sc : sc;
#pragma unroll
          for (int j = 0; j < 4; ++j) scr[kk * 33 + c4 + j] = v[i][j] * g; } }
    LDS_WAIT();
    const int c = lane & 7;
#pragma unroll
    for (int j = 0; j < 4; ++j) { const int n = (lane >> 3) + 8 * j; const LAS float* s = scr + (8 * c) * 33 + n;
        if (d.fp8) { u32x2 o; o.x = pk4_fp8(s[0 * 33], s[1 * 33], s[2 * 33], s[3 * 33]); o.y = pk4_fp8(s[4 * 33], s[5 * 33], s[6 * 33], s[7 * 33]); *(u32x2*)(d.dst + (size_t)n * d.pitch + 8 * c) = o; }
        else { u32x4 o; o.x = pk2(s[0 * 33], s[1 * 33]); o.y = pk2(s[2 * 33], s[3 * 33]); o.z = pk2(s[4 * 33], s[5 * 33]); o.w = pk2(s[6 * 33], s[7 * 33]); *(u32x4*)(d.dst + (size_t)n * d.pitch + 16 * c) = o; } }
    LDS_WAIT();
}
typedef _Float16 h32 __attribute__((ext_vector_type(32)));
typedef unsigned u32x6 __attribute__((ext_vector_type(6)));
struct T6Desc { const float* src; const float* gk; unsigned char* d16; unsigned char* d8; };
__device__ __forceinline__ T6Desc t6_decode(const Frame& F, int it) {
    const int l = it >> 14, r = it & 16383, g = r & 3, pn = (r >> 2) & 7, h = (r >> 5) & 1, t = (r >> 6) & 7, e = r >> 9;
    T6Desc d; d.src = F.in[21] + ((size_t)l * NE + e) * DM * 2048 + (size_t)(t * 128) * 2048 + h * 1024 + pn * 128 + g * 32; d.gk = F.in[18] + l * DM + t * 128;
    unsigned char* img = F.ws + WS_W + (size_t)l * WL_STRIDE + WL_GU + (size_t)((e * 8 + pn) * 8 + t) * 24576 + h * 12288;
    d.d16 = img + g * 2048; d.d8 = img + 8192 + g * 1024; return d;
}
__device__ __forceinline__ void t6_load(const T6Desc& d, f32x4 (&v)[16], int lane) {
    const unsigned o = (unsigned)(((lane >> 3) * 2048 + (lane & 7) * 4) * 4);
#pragma unroll
    for (int i = 0; i < 16; ++i) { const char* bi = (const char*)d.src + (size_t)i * (8 * 2048 * 4); asm volatile("" : "+s"(bi)); v[i] = *(const f32x4*)(bi + o); }
}
__device__ __forceinline__ void t6_finish(const T6Desc& d, const f32x4 (&v)[16], LAS float* scr, int lane) {
    { const int rr = lane >> 3, c4 = (lane & 7) * 4;
#pragma unroll
      for (int i = 0; i < 16; ++i) { const int kk = i * 8 + rr; const float g = d.gk[kk] * W8_SCALE;
#pragma unroll
          for (int j = 0; j < 4; ++j) scr[kk * 33 + c4 + j] = v[i][j] * g; } }
    LDS_WAIT();
    const int rho = lane & 31, col = pg8::perm32(rho), fqb = lane >> 5;
    u32x6 pk[2];
#pragma unroll
    for (int p = 0; p < 2; ++p) { const int fq = 2 * p + fqb; h32 hv;
#pragma unroll
        for (int i = 0; i < 32; ++i) hv[i] = (_Float16)scr[(fq * 32 + i) * 33 + col];
        pk[p] = __builtin_amdgcn_cvt_scalef32_pk32_fp6_f16(hv, 1.0f); }
    LDS_WAIT();
    LAS unsigned char* sb = (LAS unsigned char*)scr;
#pragma unroll
    for (int p = 0; p < 2; ++p) { const int fq = 2 * p + fqb, s16 = fq ^ ((0 - (rho >> 2)) & 3), s8 = fq ^ (2 * ((rho >> 3) & 1));
        *(LAS u32x4*)(sb + rho * 64 + s16 * 16) = (u32x4){pk[p][0], pk[p][1], pk[p][2], pk[p][3]};
        *(LAS u32x2*)(sb + 2048 + rho * 32 + s8 * 8) = (u32x2){pk[p][4], pk[p][5]}; }
    LDS_WAIT();
    { const u32x4 a = *(const LAS u32x4*)(sb + lane * 16), b = *(const LAS u32x4*)(sb + 1024 + lane * 16), c = *(const LAS u32x4*)(sb + 2048 + lane * 16);
      const unsigned o = (unsigned)(lane * 16); *(u32x4*)(d.d16 + o) = a; *(u32x4*)(d.d16 + (o + 1024u)) = b; *(u32x4*)(d.d8 + o) = c; }
    LDS_WAIT();
}
__device__ __forceinline__ void prologue_phase(const Frame& F) {
    LAS float* scr = (LAS float*)(F.lds + F.wave * 16384);
    constexpr int I_TOT = DEPTH * (16 * 48 + 8 * 16 + 16 * 32 + NE * 16 * 64 + NE * 16 * 32);
    if (F.gw < I_TOT) {
        int it = F.gw; TDesc cur = tdesc_decode(F, it); f32x4 vc[8]; tdesc_load(cur, vc, F.lane);
        for (;;) { const int itn = it + F.ngw; const bool hn = itn < I_TOT; TDesc nx = cur; f32x4 vn[8];
#pragma unroll
            for (int i = 0; i < 8; ++i) vn[i] = vc[i];
            if (hn) { nx = tdesc_decode(F, itn); tdesc_load(nx, vn, F.lane); }
            tdesc_finish(cur, vc, scr, F.lane);
            if (!hn) break;
            cur = nx; it = itn;
#pragma unroll
            for (int i = 0; i < 8; ++i) vc[i] = vn[i]; }
    }
    if (GU_FP6) {
        __syncthreads();
        LAS float* scr6 = (LAS float*)(F.lds + F.wave * 16896);
        constexpr int I6 = DEPTH * 16384;
        if (F.gw < I6) { int it = F.gw; T6Desc dA = t6_decode(F, it), dB = dA; f32x4 vA[16], vB[16];
            t6_load(dA, vA, F.lane);
            for (;;) {
                const bool hb = it + F.ngw < I6; if (hb) { dB = t6_decode(F, it + F.ngw); t6_load(dB, vB, F.lane); }
                t6_finish(dA, vA, scr6, F.lane); if (!hb) break; it += F.ngw;
                const bool ha = it + F.ngw < I6; if (ha) { dA = t6_decode(F, it + F.ngw); t6_load(dA, vA, F.lane); }
                t6_finish(dB, vB, scr6, F.lane); if (!ha) break; it += F.ngw; } } }
    { const float* x = F.in[0]; bf16* xb = wsp<bf16>(F, WS_XBF); unsigned char* xq = wsp<unsigned char>(F, WS_XQ); float* rs = wsp<float>(F, WS_RSTD0);
      for (int tok0 = 2 * F.gw; tok0 < NTOK; tok0 += 2 * F.ngw) { f32x4 v[2][4];
#pragma unroll
          for (int r = 0; r < 2; ++r)
#pragma unroll
              for (int j = 0; j < 4; ++j) v[r][j] = *(const f32x4*)(x + (size_t)(tok0 + r) * DM + 4 * F.lane + 256 * j);
#pragma unroll
          for (int r = 0; r < 2; ++r) { const size_t tok = tok0 + r; float ss = 0.f, am = 0.f;
#pragma unroll
              for (int j = 0; j < 4; ++j) { ss += (v[r][j][0] * v[r][j][0] + v[r][j][1] * v[r][j][1]) + (v[r][j][2] * v[r][j][2] + v[r][j][3] * v[r][j][3]);
                  am = fmaxf(am, fmaxf(fmaxf(fabsf(v[r][j][0]), fabsf(v[r][j][1])), fmaxf(fabsf(v[r][j][2]), fabsf(v[r][j][3])))); }
              ss = wave_sum_dpp(ss); am = wave_max_dpp(am);
              const float sc = am > 0.f ? am * (1.0f / 127.0f) : 1.0f, qs = 1.0f / sc;
#pragma unroll
              for (int j = 0; j < 4; ++j) { u32x2 w; w.x = pk2(v[r][j][0], v[r][j][1]); w.y = pk2(v[r][j][2], v[r][j][3]); *(u32x2*)(xb + tok * DM + 4 * F.lane + 256 * j) = w;
                  *(unsigned*)(xq + tok * DM + 4 * F.lane + 256 * j) = pk4_i8(v[r][j][0] * qs, v[r][j][1] * qs, v[r][j][2] * qs, v[r][j][3] * qs); }
              if (F.lane == 0) rs[tok] = __builtin_amdgcn_rsqf(ss * (1.0f / DM) + EPS) * sc; } } }
    { float* fold = wsp<float>(F, WS_FOLD);
      for (int q = blockIdx.x * NTHREADS + F.tid; q < DEPTH * DM * 64; q += F.G * NTHREADS) { const int l = q / (DM * 64), k = (q >> 6) & (DM - 1), id4 = (q & 63) * 4, i = id4 >> 6, d = id4 & 63;
          const float* wrow = F.in[2] + ((size_t)l * DM + k) * INW + 512 + 64 * i; const float* pw = F.in[13] + ((size_t)(l * 4 + i) * 64) * 64 + d; f32x4 acc = {0.f, 0.f, 0.f, 0.f};
#pragma unroll 4
          for (int c4 = 0; c4 < 16; ++c4) { const f32x4 wv = *(const f32x4*)(wrow + 4 * c4);
#pragma unroll
              for (int j = 0; j < 4; ++j) acc += wv[j] * *(const f32x4*)(pw + (4 * c4 + j) * 64); }
          const float g = F.in[1][l * DM + k];
#pragma unroll
          for (int j = 0; j < 4; ++j) fold[((size_t)l * 256 + id4 + j) * DM + k] = acc[j] * g; } }
    { unsigned* cmax = wsp<unsigned>(F, WS_CTL) + CW_CMAX;
      for (int it = F.gw; it < DEPTH * 16 * 48; it += F.ngw) { const int l = it / 768, r = it % 768, kb = r / 48, nb = r % 48; if (nb >= 16 && nb < 24) continue;
          const int rr = F.lane >> 3, c4 = (F.lane & 7) * 4; const float* src = F.in[2] + ((size_t)l * DM + kb * 64) * INW + nb * 32 + c4; const float* g = F.in[1] + l * DM + kb * 64;
          f32x4 m = {0.f, 0.f, 0.f, 0.f};
#pragma unroll
          for (int i = 0; i < 8; ++i) { const f32x4 v = *(const f32x4*)(src + (size_t)(i * 8 + rr) * INW); const float gg = fabsf(g[i * 8 + rr]);
#pragma unroll
              for (int j = 0; j < 4; ++j) m[j] = fmaxf(m[j], fabsf(v[j]) * gg); }
#pragma unroll
          for (int j = 0; j < 4; ++j) { float t = m[j]; t = fmaxf(t, shx(t, 8, F.lane)); t = fmaxf(t, shx(t, 16, F.lane)); t = fmaxf(t, shx(t, 32, F.lane));
              if (F.lane < 8) atomicMax(cmax + l * INW + nb * 32 + c4 + j, __float_as_uint(t)); } } }
    { float* wr = wsp<float>(F, WS_WR);
      for (int i = blockIdx.x * NTHREADS + F.tid; i < DEPTH * NE * DM; i += F.G * NTHREADS) { const int l = i / (NE * DM), e = (i / DM) % NE, k = i % DM;
          wr[i] = F.in[18][l * DM + k] * F.in[19][((size_t)l * DM + k) * NE + e]; } }
    { f32x4* sa = wsp<f32x4>(F, WS_SSMA); float* sb = wsp<float>(F, WS_SSMB); f32x2* apw = wsp<f32x2>(F, WS_APOW);
      for (int q = blockIdx.x * NTHREADS + F.tid; q < DEPTH * NG * SP * 33; q += F.G * NTHREADS) { const int i = q / 33, j = q - i * 33, lg = i / SP;
          const float lr = fminf(F.in[3][i], -1e-4f), li = F.in[4][i], step = __expf(F.in[10][lg]);
          const float mj = __expf((float)j * lr * step), aj = (float)j * (li * step), pr = mj * cosf(aj), pi = mj * sinf(aj);
          apw[q] = (f32x2){pr, pi};
          if (j == 1) { const float ar = pr, ai = pi; const float m32 = __expf(32.0f * lr * step), a32 = 32.0f * (li * step);
              sa[i] = (f32x4){ar, ai, m32 * cosf(a32), m32 * sinf(a32)};
              const float nr = ar - 1.0f, den = lr * lr + li * li, kr = (nr * lr + ai * li) / den, ki = (ai * lr - nr * li) / den;
#pragma unroll
              for (int h = 0; h < 16; ++h) { const float br = F.in[5][(size_t)i * 16 + h], bi = F.in[6][(size_t)i * 16 + h];
                  sb[(size_t)i * 32 + h] = kr * br - ki * bi; sb[(size_t)i * 32 + 16 + h] = kr * bi + ki * br; } } } }
}

__device__ __forceinline__ void winq_phase(const Frame& F) {
    const unsigned* cmax = wsp<unsigned>(F, WS_CTL) + CW_CMAX; float* sw = wsp<float>(F, WS_SWIN); const float* fold = wsp<float>(F, WS_FOLD);
    LAS float* scr = (LAS float*)(F.lds + 32768 + F.wave * 8704);
    for (int it = F.gw; it < DEPTH * 16 * 48; it += F.ngw) { const int l = it / 768, r = it % 768, kb = r / 48, nb = r % 48; if (nb >= 16 && nb < 24) continue;
        unsigned char* wq = F.ws + WS_W + (size_t)l * WL_STRIDE + WL_IN;
        const int rr = F.lane >> 3, c4 = (F.lane & 7) * 4; const float* src = F.in[2] + ((size_t)l * DM + kb * 64) * INW + nb * 32 + c4; const float* g = F.in[1] + l * DM + kb * 64;
#pragma unroll
        for (int i = 0; i < 8; ++i) { const f32x4 v = *(const f32x4*)(src + (size_t)(i * 8 + rr) * INW); const float gg = g[i * 8 + rr];
#pragma unroll
            for (int j = 0; j < 4; ++j) scr[(i * 8 + rr) * 33 + c4 + j] = v[j] * gg; }
        LDS_WAIT();
        const int c = F.lane & 7;
#pragma unroll
        for (int j = 0; j < 4; ++j) { const int n = (F.lane >> 3) + 8 * j; const LAS float* t = scr + (8 * c) * 33 + n;
            const float cm = __uint_as_float(__hip_atomic_load(cmax + l * INW + nb * 32 + n, __ATOMIC_RELAXED, __HIP_MEMORY_SCOPE_AGENT)); const float qs = cm > 0.f ? 127.0f / cm : 0.f;
            u32x2 o; o.x = pk4_i8(t[0 * 33] * qs, t[1 * 33] * qs, t[2 * 33] * qs, t[3 * 33] * qs); o.y = pk4_i8(t[4 * 33] * qs, t[5 * 33] * qs, t[6 * 33] * qs, t[7 * 33] * qs);
            *(u32x2*)(wq + (size_t)(nb * 32 + n) * DM + kb * 64 + 8 * c) = o;
            if (kb == 0 && c == 0) sw[l * INW + nb * 32 + n] = cm * (1.0f / 127.0f); }
        LDS_WAIT();
    }
    for (int cid = F.gw; cid < DEPTH * 256; cid += F.ngw) { const int l = cid >> 8, id = cid & 255;
        const float* fp = fold + ((size_t)l * 256 + id) * DM + 16 * F.lane; f32x4 v[4]; float am = 0.f;
#pragma unroll
        for (int j = 0; j < 4; ++j) { v[j] = *(const f32x4*)(fp + 4 * j); am = fmaxf(am, fmaxf(fmaxf(fabsf(v[j][0]), fabsf(v[j][1])), fmaxf(fabsf(v[j][2]), fabsf(v[j][3])))); }
        am = wave_max(am); const float qs = am > 0.f ? 127.0f / am : 0.f;
        u32x4 o;
#pragma unroll
        for (int j = 0; j < 4; ++j) o[j] = pk4_i8(v[j][0] * qs, v[j][1] * qs, v[j][2] * qs, v[j][3] * qs);
        *(u32x4*)(F.ws + WS_W + (size_t)l * WL_STRIDE + WL_IN + (size_t)(512 + id) * DM + 16 * F.lane) = o;
        if (F.lane == 0) sw[l * INW + 512 + id] = am * (1.0f / 127.0f); }
}
__device__ __forceinline__ void ktab_phase(const Frame& F) {
    LAS float* Cr = (LAS float*)F.lds; LAS float* Ci = Cr + 1024; LAS float* Br = Ci + 1024; LAS float* Bi = Br + 1024; LAS f32x2* Ap = (LAS f32x2*)(Bi + 1024);
    const float* sb = wsp<float>(F, WS_SSMB); const f32x2* ap = wsp<f32x2>(F, WS_APOW); float* kt = wsp<float>(F, WS_KTAB);
    for (int item = blockIdx.x; item < DEPTH * NG * 4; item += F.G) { const int lg = item >> 2, part = item & 3;
        __syncthreads();
        for (int i = F.tid; i < 1024; i += NTHREADS) { Cr[i] = F.in[7][(size_t)lg * 1024 + i]; Ci[i] = F.in[8][(size_t)lg * 1024 + i];
            const int p = i >> 4, h = i & 15; Br[i] = sb[((size_t)lg * SP + p) * 32 + h]; Bi[i] = sb[((size_t)lg * SP + p) * 32 + 16 + h]; }
        for (int i = F.tid; i < SP * 33; i += NTHREADS) Ap[i] = ap[(size_t)lg * SP * 33 + i];
        __syncthreads();
        for (int e = part * 2048 + F.tid; e < (part + 1) * 2048; e += NTHREADS) { const int j = e >> 8, h = (e >> 4) & 15, hp = e & 15; float acc = 0.f;
            for (int p = 0; p < SP; ++p) { const f32x2 a = Ap[p * 33 + j]; const float br = Br[p * 16 + hp], bi = Bi[p * 16 + hp]; const float wr = a[0] * br - a[1] * bi, wi = a[0] * bi + a[1] * br;
                acc += Cr[h * 64 + p] * wr - Ci[h * 64 + p] * wi; }
            kt[(size_t)lg * 8192 + e] = acc; }
    }
}
__device__ __forceinline__ void expand_phase(const Frame& F) {
    const float* __restrict__ sb = wsp<float>(F, WS_SSMB); const f32x2* __restrict__ ap = wsp<f32x2>(F, WS_APOW); const float* __restrict__ kt = wsp<float>(F, WS_KTAB);
    const float* __restrict__ cre = F.in[7]; const float* __restrict__ cim = F.in[8];
    bf16* __restrict__ TZ = wsp<bf16>(F, WS_TZ); bf16* __restrict__ PZ = wsp<bf16>(F, WS_PZ);
    constexpr int NTZ = DEPTH * NG * 512 * 80, NPZ = DEPTH * 16 * 256 * 160;
#pragma unroll 4
    for (int q = blockIdx.x * NTHREADS + F.tid; q < NTZ + NPZ; q += F.G * NTHREADS) {
        float v[8];
#pragma unroll
        for (int j = 0; j < 8; ++j) v[j] = 0.f;
        bf16* dst;
        if (q < NTZ) { const int kp = q % 80, n = (q / 80) & 511, lg = q / (80 * 512); const int k0 = kp * 8, t = n >> 4, h = n & 15;
            dst = TZ + ((size_t)lg * 512 + n) * UK + k0;
            if (k0 < 512) { const int s = k0 >> 4, h0 = k0 & 15;
                if (t >= s) { const float* kp2 = kt + ((size_t)lg * 32 + (t - s)) * 256 + h * 16 + h0; const f32x4 a = *(const f32x4*)kp2, b = *(const f32x4*)(kp2 + 4);
                    v[0] = a[0]; v[1] = a[1]; v[2] = a[2]; v[3] = a[3]; v[4] = b[0]; v[5] = b[1]; v[6] = b[2]; v[7] = b[3]; } }
            else { const int kk = k0 - 512, cpart = kk >> 6, p0 = kk & 63;
#pragma unroll
                for (int j = 0; j < 8; ++j) { const int p = p0 + j; const f32x2 a = ap[((size_t)lg * SP + p) * 33 + t + 1]; const float cr = cre[((size_t)lg * 16 + h) * SP + p], ci = cim[((size_t)lg * 16 + h) * SP + p];
                    v[j] = cpart == 0 ? (cr * a[0] - ci * a[1]) : -(cr * a[1] + ci * a[0]); } } }
        else { const int q2 = q - NTZ; const int kp = q2 % 160, n = (q2 / 160) & 255, lp = q2 / (160 * 256); const int l = lp >> 4, pair = lp & 15;
            const int k0 = kp * 8, half = n >> 7, cpart = (n >> 6) & 1, p = n & 63, g = 2 * pair + half, krel = k0 - half * UK;
            dst = PZ + ((size_t)lp * 256 + n) * 1280 + k0;
            if (krel >= 0 && krel < 512) { const int s = krel >> 4, h0 = krel & 15; const size_t gp = (size_t)(l * NG + g) * SP + p; const f32x2 w = ap[gp * 33 + 31 - s];
#pragma unroll
                for (int j = 0; j < 8; ++j) { const float br = sb[gp * 32 + h0 + j], bi = sb[gp * 32 + 16 + h0 + j]; v[j] = cpart == 0 ? (w[0] * br - w[1] * bi) : (w[0] * bi + w[1] * br); } } }
        u32x4 w; w.x = pk2(v[0], v[1]); w.y = pk2(v[2], v[3]); w.z = pk2(v[4], v[5]); w.w = pk2(v[6], v[7]);
        *(u32x4*)dst = w;
    }
}

__device__ __forceinline__ void ld4(const bf16* p, float (&v)[4]) { const u32x2 w = *(const u32x2*)p; v[0] = bflo(w.x); v[1] = bfhi(w.x); v[2] = bflo(w.y); v[3] = bfhi(w.y); }
__device__ __forceinline__ void poolconv_body(const Frame& F, int l, int item, const bf16* __restrict__ proj, bf16* __restrict__ mix) {
    const int lane = F.lane, c4 = lane * 4, tok0 = item * 32, pos0 = tok0 & (SEQ - 1), w = 2 << (lane >> 4);
    const bf16* base = proj + (size_t)tok0 * INW + c4;
    float cw[3][4], ps[4];
#pragma unroll
    for (int k = 0; k < 3; ++k) { const f32x4 t = *(const f32x4*)(F.in[15] + (l * 3 + k) * 256 + c4); cw[k][0] = t[0]; cw[k][1] = t[1]; cw[k][2] = t[2]; cw[k][3] = t[3]; }
    { const f32x4 t = *(const f32x4*)(F.in[14] + l * 256 + c4); ps[0] = t[0]; ps[1] = t[1]; ps[2] = t[2]; ps[3] = t[3]; }
    float z2[4] = {0.f, 0.f, 0.f, 0.f}, z1[4] = {0.f, 0.f, 0.f, 0.f}, ws[4] = {0.f, 0.f, 0.f, 0.f};
    if (pos0 > 0) {
        float a[4], b[4];
        ld4(base - 2 * INW + 1024, a); ld4(base - 2 * INW + 1280, b);
#pragma unroll
        for (int j = 0; j < 4; ++j) z2[j] = a[j] * b[j];
        ld4(base - 1 * INW + 1024, a); ld4(base - 1 * INW + 1280, b);
#pragma unroll
        for (int j = 0; j < 4; ++j) z1[j] = a[j] * b[j];
#pragma unroll
        for (int k = 1; k <= 16; ++k) { if (k <= w) { float q[4]; ld4(base - k * INW + 512, q);
#pragma unroll
            for (int j = 0; j < 4; ++j) ws[j] += q[j]; } }
    }
    u32x2 La[4][5], Lb[4][5];
#define PC_LOAD(L, t0) do { _Pragma("unroll") for (int tt = 0; tt < 4; ++tt) { const bf16* row = base + (size_t)((t0) + tt) * INW; const bool drop_ = (pos0 + (t0) + tt) >= w; \
        L[tt][0] = *(const u32x2*)(row + 512); L[tt][1] = *(const u32x2*)(row + 768); L[tt][2] = *(const u32x2*)(row + 1024); L[tt][3] = *(const u32x2*)(row + 1280); \
        L[tt][4] = *(const u32x2*)(drop_ ? row - w * INW + 512 : row + 512); } } while (0)
#define PC_UNPK(v, W_) do { const u32x2 w2_ = (W_); v[0] = bflo(w2_.x); v[1] = bfhi(w2_.x); v[2] = bflo(w2_.y); v[3] = bfhi(w2_.y); } while (0)
#define PC_COMP(L, t0) do { _Pragma("unroll") for (int tt = 0; tt < 4; ++tt) { const int t = (t0) + tt, pos = pos0 + t; \
        float q[4], qo[4], bg[4], cg[4], hv[4]; PC_UNPK(q, L[tt][0]); PC_UNPK(bg, L[tt][1]); PC_UNPK(cg, L[tt][2]); PC_UNPK(hv, L[tt][3]); PC_UNPK(qo, L[tt][4]); \
        const bool drop = pos >= w; const float inv = 1.0f / (float)((pos + 1) < w ? (pos + 1) : w); \
        float po[4], co[4], sp = 0.f, sc = 0.f; \
        _Pragma("unroll") for (int j = 0; j < 4; ++j) { ws[j] += q[j]; if (drop) ws[j] -= qo[j]; po[j] = (ws[j] * inv - q[j]) * ps[j]; sp += po[j] * po[j]; \
            const float z0 = cg[j] * hv[j]; co[j] = bg[j] * (cw[0][j] * z2[j] + cw[1][j] * z1[j] + cw[2][j] * z0); sc += co[j] * co[j]; z2[j] = z1[j]; z1[j] = z0; } \
        const float rp = __builtin_amdgcn_rsqf(wave_sum_dpp(sp) * (1.0f / 256) + EPS), rc = __builtin_amdgcn_rsqf(wave_sum_dpp(sc) * (1.0f / 256) + EPS); \
        u32x2 wa; wa.x = pk2(po[0] * rp, po[1] * rp); wa.y = pk2(po[2] * rp, po[3] * rp); u32x2 wb; wb.x = pk2(co[0] * rc, co[1] * rc); wb.y = pk2(co[2] * rc, co[3] * rc); \
        if (DBG_SKIP & 4) { wa.x = 0; wa.y = 0; } if (DBG_SKIP & 8) { wb.x = 0; wb.y = 0; } \
        bf16* mr = mix + (size_t)(tok0 + t) * DM + c4; *(u32x2*)(mr + 512) = wa; *(u32x2*)(mr + 768) = wb; } } while (0)
    PC_LOAD(La, 0);
    for (int t0 = 0; t0 < 32; t0 += 8) {
        PC_LOAD(Lb, t0 + 4);
        PC_COMP(La, t0);
        if (t0 + 8 < 32) PC_LOAD(La, t0 + 8);
        PC_COMP(Lb, t0 + 4);
    }
#undef PC_LOAD
#undef PC_UNPK
#undef PC_COMP
}
__device__ __forceinline__ void poolconv_item(const Frame& F, int l, int item) { poolconv_body(F, l, item, wsp<bf16>(F, WS_PROJ), wsp<bf16>(F, WS_MIX)); }

__device__ __forceinline__ void ssm_carry_lds(const Frame& F, int l, int b, int g) {
    bf16* UB = wsp<bf16>(F, WS_UB);
    const LAS float* Sl = (const LAS float*)F.lds; LAS f32x2* ends = (LAS f32x2*)(F.lds + MISC_OFF + 6144);
    const int p = F.tid & 63, seg = F.tid >> 6;
    const f32x4 a = wsp<f32x4>(F, WS_SSMA)[(l * NG + g) * SP + p]; const float Ar = a[2], Ai = a[3];
    __syncthreads();
    float pr[32], pi[32]; float hr = 0.f, hi = 0.f;
#pragma unroll
    for (int j = 0; j < 32; ++j) { pr[j] = Sl[(seg * 32 + j) * SPITCH + p]; pi[j] = Sl[(seg * 32 + j) * SPITCH + 64 + p]; }
#pragma unroll
    for (int j = 0; j < 32; ++j) { const float sr = pr[j], si = pi[j]; pr[j] = hr; pi[j] = hi;
        const float nr = Ar * hr - Ai * hi + sr, ni = Ar * hi + Ai * hr + si; hr = nr; hi = ni; }
    ends[seg * 64 + p] = (f32x2){hr, hi};
    float Br = Ar, Bi = Ai;
#pragma unroll
    for (int q = 0; q < 5; ++q) { const float t = Br * Br - Bi * Bi; Bi = 2.0f * Br * Bi; Br = t; }
    __syncthreads();
    float gr = 0.f, gi = 0.f;
    for (int q = 0; q < seg; ++q) { const f32x2 e = ends[q * 64 + p]; const float nr = Br * gr - Bi * gi + e[0], ni = Br * gi + Bi * gr + e[1]; gr = nr; gi = ni; }
#pragma unroll
    for (int j = 0; j < 32; ++j) { const unsigned o = (unsigned)(((b * NCH + seg * 32 + j) * NG + g) * UK + 512 + p);
        const float vr = gr + pr[j], vi = gi + pi[j];
        UB[o] = (bf16)(pk2(vr, vr) & 0xffffu); UB[o + 64] = (bf16)(pk2(vi, vi) & 0xffffu);
        const float nr = Ar * gr - Ai * gi, ni = Ar * gi + Ai * gr; gr = nr; gi = ni; }
}

constexpr int RW_PITCH = 2064;
__device__ __forceinline__ float row16_max(float v, int ln) { v = fmaxf(v, shx(v, 1, ln)); v = fmaxf(v, shx(v, 2, ln)); v = fmaxf(v, shx(v, 4, ln)); v = fmaxf(v, shx(v, 8, ln)); return v; }
__device__ __forceinline__ int row16_min(int v, int ln) { int t; t = shxi(v, 1, ln); v = t < v ? t : v; t = shxi(v, 2, ln); v = t < v ? t : v; t = shxi(v, 4, ln); v = t < v ? t : v; t = shxi(v, 8, ln); v = t < v ? t : v; return v; }
__device__ __forceinline__ void route_phase(const Frame& F, int l, const bf16* X1) {
    LAS unsigned char* Wh = F.lds; LAS unsigned char* Wl = F.lds + 32 * RW_PITCH;
    LAS int* lcount = (LAS int*)(F.lds + MISC_OFF + 512); LAS int* gbase = (LAS int*)(F.lds + MISC_OFF + 640);
    LAS u32x2* tokrec = (LAS u32x2*)(F.lds + MISC_OFF + 1024);
    LAS float* rsl = (LAS float*)(F.lds + MISC_OFF + 5120);
    const float* wr = wsp<float>(F, WS_WR) + (size_t)l * NE * DM; const float* rb = F.in[20] + l * NE;
    float* rowg = wsp<float>(F, WS_ROWG); float* rowr = wsp<float>(F, WS_ROWR); int* rowl = wsp<int>(F, WS_ROWL);
    unsigned* gcount = wsp<unsigned>(F, WS_CTL) + CW_CNT + l * NE;
    for (int i = F.tid * 4; i < NE * DM; i += NTHREADS * 4) { const f32x4 w = *(const f32x4*)(wr + i); const int e = i >> 10, k = i & 1023;
        const unsigned h0 = pk2(w[0], w[1]), h1 = pk2(w[2], w[3]);
        const unsigned l0 = pk2(w[0] - bflo(h0), w[1] - bfhi(h0)), l1 = pk2(w[2] - bflo(h1), w[3] - bfhi(h1));
        *(LAS u32x2*)(Wh + e * RW_PITCH + k * 2) = (u32x2){h0, h1}; *(LAS u32x2*)(Wl + e * RW_PITCH + k * 2) = (u32x2){l0, l1}; }
    if (F.tid < 32) lcount[F.tid] = 0;
    __syncthreads();
    const int lane = F.lane, tr = lane & 15, kq = lane >> 4;
    const float b0 = rb[tr], b1 = rb[tr + 16];
    for (int batch = blockIdx.x; batch < NTOK / 128; batch += F.G) {
        const int tok0 = batch * 128 + F.wave * 16;
        f32x4 d0 = {0.f, 0.f, 0.f, 0.f}, d1 = {0.f, 0.f, 0.f, 0.f}; float ssq = 0.f;
        const bf16* xp = X1 + (size_t)(tok0 + tr) * DM + kq * 8;
        const LAS unsigned char* whp = Wh + tr * RW_PITCH + kq * 16; const LAS unsigned char* wlp = Wl + tr * RW_PITCH + kq * 16;
        u32x4 xrow[32];
#pragma unroll
        for (int ks = 0; ks < 32; ++ks) xrow[ks] = *(const u32x4*)(xp + ks * 32);
#pragma unroll
        for (int ks = 0; ks < 32; ++ks) {
            const u32x4 xh = xrow[ks];
            { const float f0 = bflo(xh.x), f1 = bfhi(xh.x), f2 = bflo(xh.y), f3 = bfhi(xh.y), f4 = bflo(xh.z), f5 = bfhi(xh.z), f6 = bflo(xh.w), f7 = bfhi(xh.w);
              ssq += ((f0 * f0 + f1 * f1) + (f2 * f2 + f3 * f3)) + ((f4 * f4 + f5 * f5) + (f6 * f6 + f7 * f7)); }
            const bf16x8 ah = __builtin_bit_cast(bf16x8, xh);
            const bf16x8 wh0 = *(const LAS bf16x8*)(whp + ks * 64), wh1 = *(const LAS bf16x8*)(whp + 16 * RW_PITCH + ks * 64);
            const bf16x8 wl0 = *(const LAS bf16x8*)(wlp + ks * 64), wl1 = *(const LAS bf16x8*)(wlp + 16 * RW_PITCH + ks * 64);
            d0 = __builtin_amdgcn_mfma_f32_16x16x32_bf16(ah, wh0, d0, 0, 0, 0); d1 = __builtin_amdgcn_mfma_f32_16x16x32_bf16(ah, wh1, d1, 0, 0, 0);
            d0 = __builtin_amdgcn_mfma_f32_16x16x32_bf16(ah, wl0, d0, 0, 0, 0); d1 = __builtin_amdgcn_mfma_f32_16x16x32_bf16(ah, wl1, d1, 0, 0, 0);
        }
        ssq += shx(ssq, 16, lane); ssq += shx(ssq, 32, lane);
        const float rstd = __builtin_amdgcn_rsqf(ssq * (1.0f / DM) + EPS);
#pragma unroll
        for (int r = 0; r < 4; ++r) { const int ti = 4 * kq + r; const float rs = shl_(rstd, ti);
            float v0 = d0[r] * rs + b0, v1 = d1[r] * rs + b1; int es[4]; float tv[4];
#pragma unroll
            for (int k = 0; k < 4; ++k) { const float mx = row16_max(fmaxf(v0, v1), lane); const int cand = (v0 == mx) ? tr : ((v1 == mx) ? tr + 16 : 1000); const int em = row16_min(cand, lane);
                es[k] = em; tv[k] = mx; v0 = (tr == em) ? -3.0e38f : v0; v1 = (tr + 16 == em) ? -3.0e38f : v1; }
            float p[4], sum = 0.f;
#pragma unroll
            for (int k = 0; k < 4; ++k) { p[k] = __expf(tv[k] - tv[0]); sum += p[k]; }
            const float inv = 1.0f / sum;
            if (tr < 4) { const int ee = tr == 0 ? es[0] : tr == 1 ? es[1] : tr == 2 ? es[2] : es[3]; const float gg = (tr == 0 ? p[0] : tr == 1 ? p[1] : tr == 2 ? p[2] : p[3]) * inv;
                const int slot = __hip_atomic_fetch_add(lcount + ee, 1, __ATOMIC_RELAXED, __HIP_MEMORY_SCOPE_WORKGROUP);
                u32x2 rec; rec.x = (unsigned)ee | ((unsigned)slot << 8); rec.y = __float_as_uint(gg);
                tokrec[(F.wave * 16 + ti) * 4 + tr] = rec; }
            if (tr == 4) rsl[F.wave * 16 + ti] = rs;
        }
        __syncthreads();
        if (F.tid < 32) gbase[F.tid] = (int)__hip_atomic_fetch_add(gcount + F.tid, (unsigned)lcount[F.tid], __ATOMIC_RELAXED, __HIP_MEMORY_SCOPE_AGENT);
        __syncthreads();
        { const u32x2 rec = tokrec[F.tid]; const int e = rec.x & 0xff, slot = gbase[e] + (int)(rec.x >> 8); const int tokk = batch * 512 + F.tid;
          rowl[(size_t)e * ROWCAP + slot] = tokk; rowg[(size_t)e * ROWCAP + slot] = __uint_as_float(rec.y); rowr[(size_t)e * ROWCAP + slot] = rsl[F.tid >> 2]; }
        __syncthreads();
        if (F.tid < 32) lcount[F.tid] = 0;
        __syncthreads();
    }
}
__device__ __forceinline__ void expert_tables(const Frame& F, int l) {
    LAS int* ecnt = (LAS int*)(F.lds + MISC_OFF + 64); LAS int* mbpre = (LAS int*)(F.lds + MISC_OFF + 192);
    const unsigned* gcount = wsp<unsigned>(F, WS_CTL) + CW_CNT + l * NE;
    unsigned tz = (unsigned)F.tid; asm volatile("" : "+v"(tz));
    if (tz < 32) ecnt[tz] = (int)__hip_atomic_load(gcount + tz, __ATOMIC_RELAXED, __HIP_MEMORY_SCOPE_AGENT);
    __syncthreads();
    if (F.tid == 0) { int s = 0; for (int e = 0; e < NE; ++e) { mbpre[e] = s; s += (ecnt[e] + 255) >> 8; } mbpre[NE] = s; }
    __syncthreads();
}
__device__ __forceinline__ void combine_phase(const Frame& F, int l, const bf16* X1) {
    const unsigned char* Y = wsp<unsigned char>(F, WS_Y); bf16* xb = wsp<bf16>(F, WS_XBF); float* rs = wsp<float>(F, WS_RSTD0); unsigned char* xq = wsp<unsigned char>(F, WS_XQ);
    const bool lastl = (l == DEPTH - 1); const int col = 16 * F.lane;
    for (int tok = F.gw; tok < NTOK; tok += F.ngw) { float v[16]; float ss = 0.f;
        { const u32x4 a = *(const u32x4*)(X1 + (size_t)tok * DM + col), b = *(const u32x4*)(X1 + (size_t)tok * DM + col + 8);
          v[0] = bflo(a.x); v[1] = bfhi(a.x); v[2] = bflo(a.y); v[3] = bfhi(a.y); v[4] = bflo(a.z); v[5] = bfhi(a.z); v[6] = bflo(a.w); v[7] = bfhi(a.w);
          v[8] = bflo(b.x); v[9] = bfhi(b.x); v[10] = bflo(b.y); v[11] = bfhi(b.y); v[12] = bflo(b.z); v[13] = bfhi(b.z); v[14] = bflo(b.w); v[15] = bfhi(b.w); }
#pragma unroll
        for (int k = 0; k < ((DBG_SKIP & 1) ? 0 : 4); ++k) { const u32x4 y = *(const u32x4*)(Y + ((size_t)tok * 4 + k) * DM + col);
#pragma unroll
            for (int q = 0; q < 4; ++q) { const int w = (int)y[q]; const f32x2 lo = __builtin_amdgcn_cvt_pk_f32_fp8(w, false), hi = __builtin_amdgcn_cvt_pk_f32_fp8(w, true);
                v[4 * q + 0] += lo[0] * Y8_INV; v[4 * q + 1] += lo[1] * Y8_INV; v[4 * q + 2] += hi[0] * Y8_INV; v[4 * q + 3] += hi[1] * Y8_INV; } }
#pragma unroll
        for (int j = 0; j < 16; ++j) ss += v[j] * v[j];
        const float r = __builtin_amdgcn_rsqf(wave_sum_dpp(ss) * (1.0f / DM) + EPS);
        if (!lastl) {
            u32x4 a, b; a.x = pk2(v[0], v[1]); a.y = pk2(v[2], v[3]); a.z = pk2(v[4], v[5]); a.w = pk2(v[6], v[7]); b.x = pk2(v[8], v[9]); b.y = pk2(v[10], v[11]); b.z = pk2(v[12], v[13]); b.w = pk2(v[14], v[15]);
            *(u32x4*)(xb + (size_t)tok * DM + col) = a; *(u32x4*)(xb + (size_t)tok * DM + col + 8) = b;
            float am = 0.f;
#pragma unroll
            for (int j = 0; j < 16; ++j) am = fmaxf(am, fabsf(v[j]));
            am = wave_max_dpp(am); const float sc = am > 0.f ? am * (1.0f / 127.0f) : 1.0f, qs = 1.0f / sc;
            u32x4 qv;
#pragma unroll
            for (int q = 0; q < 4; ++q) qv[q] = pk4_i8(v[4 * q] * qs, v[4 * q + 1] * qs, v[4 * q + 2] * qs, v[4 * q + 3] * qs);
            *(u32x4*)(xq + (size_t)tok * DM + col) = qv;
            if (F.lane == 0) rs[tok] = r * sc;
        } else {
#pragma unroll
            for (int q = 0; q < 4; ++q) { const f32x4 g = *(const f32x4*)(F.in[25] + col + 4 * q);
                *(f32x4*)(F.out + (size_t)tok * DM + col + 4 * q) = (f32x4){v[4 * q] * r * g[0], v[4 * q + 1] * r * g[1], v[4 * q + 2] * r * g[2], v[4 * q + 3] * r * g[3]}; }
        }
    }
}

constexpr int PH_PER_LAYER = 10, NPRO = 3, NPHASES = NPRO + DEPTH * PH_PER_LAYER;
struct Args { const float* in[26]; float* out; unsigned char* ws; int ph_lo, ph_hi, flags, pad; };
__global__ void __launch_bounds__(NTHREADS, 2) fwd(Args args) {
    extern __shared__ __attribute__((aligned(16))) unsigned char lds_raw[];
    Frame F;
    F.lds = (LAS unsigned char*)lds_raw;
    F.tid = threadIdx.x; F.lane = F.tid & 63; F.wave = __builtin_amdgcn_readfirstlane(F.tid >> 6);
    F.G = gridDim.x; F.gw = blockIdx.x * NWAVES + F.wave; F.ngw = F.G * NWAVES;
#pragma unroll
    for (int i = 0; i < 26; ++i) F.in[i] = args.in[i];
    F.out = args.out; F.ws = args.ws;
    volatile LAS unsigned* bst = (volatile LAS unsigned*)(F.lds + MISC_OFF);
    if (F.tid < 4) bst[F.tid] = 0u;
    __syncthreads();
    const int lo = args.ph_lo, hi = args.ph_hi;
    XcdBarrier bar; bar.bar = wsp<unsigned>(F, WS_CTL) + CW_BAR; bar.x = 0; bar.st = bst;
    if (hi - lo > 1) bar = xcd_barrier_post(wsp<unsigned>(F, WS_CTL) + CW_BAR, bst);
#ifndef PH_MASK
#define PH_MASK 0x7ff
#endif
#define INL(k, j) ((PH_MASK >> (j)) & 1) && (lo <= (k) && (k) < hi)
#define IN(k) (lo <= (k) && (k) < hi)
#define SEAM(k) do { if (IN(k) && IN((k) + 1)) xcd_barrier(bar, F.wave == 0 && lane_id_now() == 0); } while (0)
    LAS int* ecnt = (LAS int*)(F.lds + MISC_OFF + 64); LAS int* mbpre = (LAS int*)(F.lds + MISC_OFF + 192);

#define PHASE_FRAME() Frame Fp = F; asm volatile("" : "+s"(Fp.wave), "+s"(Fp.gw)); Fp.lane = lane_id_now(); Fp.tid = Fp.wave * 64 + Fp.lane
    if (INL(0, 0)) { PHASE_FRAME(); prologue_phase(Fp); } SEAM(0);
    if (INL(1, 0)) { PHASE_FRAME(); ktab_phase(Fp); __syncthreads(); winq_phase(Fp); } SEAM(1);
    if (INL(2, 0)) { PHASE_FRAME(); expand_phase(Fp); } SEAM(2);
    for (int l = 0; l < DEPTH; ++l) {
        const int p0 = NPRO + l * PH_PER_LAYER;
        const unsigned char* wl = F.ws + WS_W + (size_t)l * WL_STRIDE;

        if (INL(p0 + 0, 1)) { PHASE_FRAME();
            ProbInProj pb; pb.A = wsp<bf16>(Fp, WS_XQ); pb.Bt = (const bf16*)(wl + WL_IN); pb.lda = DM / 2; pb.ldb = DM / 2; pb.nM = NTOK / 256; pb.nN = INW / 256; pb.G = Fp.G; pb.c = blockIdx.x; pb.nt = DM / 128;
            pb.rowsc = wsp<float>(Fp, WS_RSTD0); pb.sw = wsp<float>(Fp, WS_SWIN) + l * INW; pb.O = wsp<bf16>(Fp, WS_PROJ); pb.UB = wsp<bf16>(Fp, WS_UB);
            pg8::gemm_phase(Fp.lds, pb, Fp.tid, (args.flags & 1) != 0);
        } SEAM(p0 + 0);
        if (INL(p0 + 1, 2)) { PHASE_FRAME();
            if (blockIdx.x < 128 && Fp.G > 128) {
                ProbSState pb; pb.UB = wsp<bf16>(Fp, WS_UB); pb.PZ = wsp<bf16>(Fp, WS_PZ) + (size_t)l * 16 * 256 * 1280; pb.Sl = (LAS float*)Fp.lds; pb.c = blockIdx.x; pb.nt = SSMW / 64; pb.ldb = 1280;
                pg8::gemm_phase(Fp.lds, pb, Fp.tid, false);
                ssm_carry_lds(Fp, l, (blockIdx.x >> 3) & 3, (blockIdx.x & 7) * 4 + (blockIdx.x >> 5));
            } else { const int nw = (Fp.G - 128) * NWAVES; for (int item = (blockIdx.x - 128) * NWAVES + Fp.wave; item < NTOK / 32; item += nw) poolconv_item(Fp, l, item); }
        } SEAM(p0 + 1);
        if (INL(p0 + 3, 4)) { PHASE_FRAME();
            ProbSsmOut pb; pb.UB = wsp<bf16>(Fp, WS_UB); pb.TZ = wsp<bf16>(Fp, WS_TZ) + (size_t)l * NG * 512 * UK; pb.dsk = Fp.in[9] + l * SSMW; pb.Z = wsp<bf16>(Fp, WS_Z); pb.G = Fp.G; pb.c = blockIdx.x; pb.nt = UK / 64; pb.ldb = UK;
            pg8::gemm_phase(Fp.lds, pb, Fp.tid, (args.flags & 1) != 0);
        } SEAM(p0 + 3);
        if (INL(p0 + 4, 5)) { PHASE_FRAME();
            ProbGlu pb; pb.A = wsp<bf16>(Fp, WS_Z); pb.Bt = (const bf16*)(wl + WL_GLU); pb.lda = SSMW; pb.ldb = SSMW; pb.nM = NTOK / 256; pb.nN = 2; pb.G = Fp.G; pb.c = blockIdx.x; pb.nt = SSMW / 64;
            pb.Z = wsp<bf16>(Fp, WS_Z); pb.bias = Fp.in[12] + l * SSMW; pb.O = wsp<bf16>(Fp, WS_MIX); pb.ssqp = wsp<float>(Fp, WS_SSQP);
            pg8::gemm_phase(Fp.lds, pb, Fp.tid, (args.flags & 1) != 0);
        } SEAM(p0 + 4);
        if (INL(p0 + 5, 6)) { PHASE_FRAME();
            ProbOutProj pb; pb.A = wsp<bf16>(Fp, WS_MIX); pb.Bt = (const bf16*)(wl + WL_OUT); pb.lda = DM; pb.ldb = DM; pb.nM = NTOK / 256; pb.nN = 4; pb.G = Fp.G; pb.c = blockIdx.x; pb.nt = DM / 64;
            pb.xres = wsp<bf16>(Fp, WS_XBF); pb.X1b = wsp<bf16>(Fp, WS_XBF1); pb.X1q = wsp<unsigned char>(Fp, WS_XQ);
            { LAS float* rsT = (LAS float*)(Fp.lds + MISC_OFF + 6144); pb.rsT = rsT;
              const float* ssqp = wsp<float>(Fp, WS_SSQP); const int rl = Fp.tid & 255;
#pragma unroll
              for (int ui = 0; ui < 2; ++ui) { Unit u;
                  if (pb.next(ui, u) && (Fp.wave >> 2) == ui) { const unsigned row = (unsigned)(u.pm * 256 + rl); const f32x4 p0 = *(const f32x4*)(ssqp + row * 8), p1 = *(const f32x4*)(ssqp + row * 8 + 4);
                      rsT[ui * 256 + rl] = __builtin_amdgcn_rsqf((((p0[0] + p0[1]) + (p0[2] + p0[3])) + ((p1[0] + p1[1]) + (p1[2] + p1[3]))) * (1.0f / SSMW) + EPS); } }
              __syncthreads(); }
            pg8::gemm_phase(Fp.lds, pb, Fp.tid, (args.flags & 1) != 0);
        } SEAM(p0 + 5);
        if (INL(p0 + 6, 7)) { PHASE_FRAME(); route_phase(Fp, l, wsp<bf16>(Fp, WS_XBF1)); } SEAM(p0 + 6);
        if (INL(p0 + 7, 8)) { PHASE_FRAME();
            expert_tables(Fp, l);
            ProbGateUp pb; pb.ecnt = ecnt; pb.mbpre = mbpre; pb.mt = Fp.lds + MISC_OFF + 1024; pb.NT = 8; pb.G = Fp.G; pb.c = blockIdx.x; pb.nt = DM / 128; pb.ldb = DM / 2;
            pb.X = wsp<unsigned char>(Fp, WS_XQ); pb.Wt = wl + WL_GU; pb.rowl = wsp<int>(Fp, WS_ROWL); pb.rowr = wsp<float>(Fp, WS_ROWR); pb.bgu = Fp.in[22] + (size_t)l * NE * 2048; pb.H = wsp<unsigned char>(Fp, WS_H);
            pg8::gemm_phase(Fp.lds, pb, Fp.tid, (args.flags & 1) != 0);
        } SEAM(p0 + 7);
        if (INL(p0 + 8, 9)) { PHASE_FRAME();
            expert_tables(Fp, l);
            ProbDown pb; pb.ecnt = ecnt; pb.mbpre = mbpre; pb.mt = Fp.lds + MISC_OFF + 1024; pb.NT = 4; pb.G = Fp.G; pb.c = blockIdx.x; pb.nt = DM / 128; pb.ldb = DM / 2;
            pb.Hm = wsp<unsigned char>(Fp, WS_H); pb.Wt = wl + WL_DN; pb.rowl = wsp<int>(Fp, WS_ROWL); pb.gate = wsp<float>(Fp, WS_ROWG); pb.bdn = Fp.in[24] + (size_t)l * NE * DM; pb.Y = wsp<unsigned char>(Fp, WS_Y);
            pg8::gemm_phase(Fp.lds, pb, Fp.tid, (args.flags & 1) != 0);
        } SEAM(p0 + 8);
        if (INL(p0 + 9, 10)) { PHASE_FRAME(); combine_phase(Fp, l, wsp<bf16>(Fp, WS_XBF1)); } SEAM(p0 + 9);
    }
#undef IN
#undef SEAM
}

extern "C" void kernel_launch(void* const* d_in, const int* in_sizes, int n_in, void* d_out, int out_size, void* d_ws, size_t ws_size, hipStream_t stream) {
    static int grid = 0;
    if (grid == 0) {
        if (n_in != 26 || out_size != NTOK * DM || ws_size < WS_END) { fprintf(stderr, "kernel_launch: unexpected shapes (n_in %d out %d ws %zu need %zu)\n", n_in, out_size, ws_size, (size_t)WS_END); grid = -1; return; }
        int dev = 0, cus = 0;
        if (hipGetDevice(&dev) != hipSuccess || hipDeviceGetAttribute(&cus, hipDeviceAttributeMultiprocessorCount, dev) != hipSuccess) { grid = -1; return; }
        if (hipFuncSetAttribute((const void*)fwd, hipFuncAttributeMaxDynamicSharedMemorySize, LDS_BYTES) != hipSuccess) { fprintf(stderr, "kernel_launch: hipFuncSetAttribute failed\n"); grid = -1; return; }
        int per_cu = 0;
        if (hipOccupancyMaxActiveBlocksPerMultiprocessor(&per_cu, (const void*)fwd, NTHREADS, LDS_BYTES) != hipSuccess || per_cu < 1) fprintf(stderr, "kernel_launch: occupancy query reports %d\n", per_cu);
        (void)hipGetLastError();
        grid = cus;
    }
    if (grid < 0) return;
    (void)hipMemsetAsync((char*)d_ws + WS_CTL, 0, CTL_ZERO_BYTES, stream);
    Args a{};
    for (int i = 0; i < 26; ++i) a.in[i] = (const float*)d_in[i];
    a.out = (float*)d_out; a.ws = (unsigned char*)d_ws;
#if defined(PROBE_DUP)
    for (int p = 0; p < NPHASES; ++p) { const int slot = p < NPRO ? 0 : 1 + (p - NPRO) % PH_PER_LAYER; const int reps = ((PROBE_DUP >> slot) & 1) ? 2 : 1;
        for (int r = 0; r < reps; ++r) { a.ph_lo = p; a.ph_hi = p + 1; a.flags = (r > 0) ? PROBE_FLAGS : 0; hipLaunchKernelGGL(fwd, dim3(grid), dim3(NTHREADS), LDS_BYTES, stream, a); } }
#elif MK_ONE_LAUNCH
    a.ph_lo = 0; a.ph_hi = NPHASES;
    hipLaunchKernelGGL(fwd, dim3(grid), dim3(NTHREADS), LDS_BYTES, stream, a);
#else
    for (int p = 0; p < NPHASES; ++p) { a.ph_lo = p; a.ph_hi = p + 1; hipLaunchKernelGGL(fwd, dim3(grid), dim3(NTHREADS), LDS_BYTES, stream, a); }
#endif
}
```

```cpp
#include <hip/hip_runtime.h>
#include <cstdio>
#include <cstdint>

#ifndef MK_ONE_LAUNCH
#define MK_ONE_LAUNCH 1
#endif
#ifndef LDS_FULLLINE
#define LDS_FULLLINE 1
#endif
#ifndef GU_FP6
#define GU_FP6 1
#endif
#ifndef DN_FP6
#define DN_FP6 1
#endif
#ifndef RING3
#define RING3 0
#endif
#ifndef DN_FP6A
#define DN_FP6A 1
#endif
#ifndef GU_FP6A
#define GU_FP6A 1
#endif
#ifndef PROBE_FLAGS
#define PROBE_FLAGS 0
#endif
#ifndef DBG_SKIP
#define DBG_SKIP 0
#endif

#define GAS __attribute__((address_space(1)))
#define LAS __attribute__((address_space(3)))
typedef unsigned short bf16;
typedef short bf16x8 __attribute__((ext_vector_type(8)));
typedef float f32x4 __attribute__((ext_vector_type(4)));
typedef float f32x2 __attribute__((ext_vector_type(2)));
typedef unsigned u32x4 __attribute__((ext_vector_type(4)));
typedef unsigned u32x2 __attribute__((ext_vector_type(2)));
typedef int v8i __attribute__((ext_vector_type(8)));
typedef int v6i __attribute__((ext_vector_type(6)));
typedef _Float16 h32 __attribute__((ext_vector_type(32)));
typedef unsigned u32x6 __attribute__((ext_vector_type(6)));
typedef int v4i __attribute__((ext_vector_type(4)));

constexpr int NTOK = 32768, DM = 1024, SEQ = 8192, NBATCH = 4, INW = 1536, NE = 32, TOPK = 4, DEPTH = 2;
constexpr int SSMW = 512, NG = 32, SP = 64, CH = 32, NCH = SEQ / CH, NCOL = NBATCH * NCH, UK = 640, ULD = NG * UK;
constexpr float EPS = 1e-5f;
constexpr int NWAVES = 8, NTHREADS = 512;
constexpr int X6KT = 128, X6ROW = 8 * X6KT;
constexpr int ROWCAP = 32768;
constexpr int MAXMB = NTOK * TOPK / 256 + NE;

constexpr size_t MiB = 1u << 20;
constexpr size_t WS_CTL = 0, CTL_ZERO_BYTES = 128 * 1024;
constexpr size_t WS_RSTD0 = 1 * MiB;
constexpr size_t WS_RSTD1 = WS_RSTD0 + 128 * 1024;
constexpr size_t WS_GATE = WS_RSTD1 + 128 * 1024;
constexpr size_t WS_SSQP = 2 * MiB;
constexpr size_t WS_ROWL = 3 * MiB;
constexpr size_t WS_WR = 7 * MiB;
constexpr size_t WS_SSMA = WS_WR + 256 * 1024;
constexpr size_t WS_SSMB = WS_SSMA + 64 * 1024;
constexpr size_t WS_S = 8 * MiB;
constexpr size_t WS_XA = 24 * MiB;
constexpr size_t WS_XB = WS_XA + 128 * MiB;
constexpr size_t WS_XBF = WS_XB + 128 * MiB;
constexpr size_t WS_XBF1 = WS_XBF + 64 * MiB;
constexpr size_t WS_PROJ = WS_XBF1 + 64 * MiB;
constexpr size_t WS_Z = WS_PROJ + 96 * MiB;
constexpr size_t WS_MIX = WS_Z + 32 * MiB;
constexpr size_t WS_H = WS_MIX + 64 * MiB;
constexpr size_t WS_Y = WS_H + 272 * MiB;
constexpr size_t WS_W = WS_Y + 256 * MiB;
constexpr size_t WL_IN = 0, WL_GLU = 3 * MiB, WL_OUT = 4 * MiB, WL_GU = 6 * MiB, WL_DN = 134 * MiB, WL_STRIDE = 198 * MiB;
constexpr size_t WS_UB = WS_W + 2 * WL_STRIDE;
constexpr size_t WS_APOW = WS_UB + 40 * MiB;
constexpr size_t WS_KTAB = WS_APOW + 2 * MiB;
constexpr size_t WS_TZ = WS_KTAB + 2 * MiB;
constexpr size_t WS_PZ = WS_TZ + 40 * MiB;
constexpr size_t WS_ROWG = WS_PZ + 20 * MiB;
constexpr size_t WS_ROWR = WS_ROWG + 4 * MiB;
constexpr size_t WS_XQ = WS_ROWR + 4 * MiB;
constexpr size_t WS_END = WS_XQ + 32 * MiB;
constexpr float Y8_SCALE = 16.0f, Y8_INV = 1.0f / 16.0f;
constexpr float W8_SCALE = 64.0f, W8_INV = 1.0f / 64.0f;
constexpr int CW_BAR = 1024;
constexpr int CW_CNT = 8192;
constexpr int CW_CMAX = 16384;
constexpr size_t WS_SWIN = WS_RSTD1;
constexpr size_t WS_FOLD = WS_XA;

constexpr int RING_BYTES = 131072;
constexpr int MISC_OFF = 150528;
constexpr int LDS_BYTES = MISC_OFF + 12288;
constexpr int SPITCH = 132;

__device__ __forceinline__ unsigned pk2(float lo, float hi) { unsigned r; asm("v_cvt_pk_bf16_f32 %0, %1, %2" : "=v"(r) : "v"(lo), "v"(hi)); return r; }
__device__ __forceinline__ unsigned pk4_fp8(float a, float b, float c, float d) { int w = 0; w = __builtin_amdgcn_cvt_pk_fp8_f32(a, b, w, false); w = __builtin_amdgcn_cvt_pk_fp8_f32(c, d, w, true); return (unsigned)w; }
__device__ __forceinline__ float bflo(unsigned w) { return __uint_as_float(w << 16); }
__device__ __forceinline__ float bfhi(unsigned w) { return __uint_as_float(w & 0xffff0000u); }
__device__ __forceinline__ float bf1(bf16 b) { return __uint_as_float(((unsigned)b) << 16); }
__device__ __forceinline__ int lane_id_now() { int l; asm volatile("v_mbcnt_lo_u32_b32 %0, -1, 0\n\tv_mbcnt_hi_u32_b32 %0, -1, %0" : "=v"(l)); return l; }
__device__ __forceinline__ float shx(float v, int m, int lane) { return __builtin_bit_cast(float, __builtin_amdgcn_ds_bpermute((lane ^ m) << 2, __builtin_bit_cast(int, v))); }
__device__ __forceinline__ int shxi(int v, int m, int lane) { return __builtin_amdgcn_ds_bpermute((lane ^ m) << 2, v); }
__device__ __forceinline__ float shl_(float v, int src) { return __builtin_bit_cast(float, __builtin_amdgcn_ds_bpermute(src << 2, __builtin_bit_cast(int, v))); }
__device__ __forceinline__ float wave_sum(float v) { const int ln = lane_id_now();
#pragma unroll
    for (int o = 1; o < 64; o <<= 1) v += shx(v, o, ln);
    return v;
}
__device__ __forceinline__ float dpp_shr(float v, int ctrl_sel) { const int iv = __builtin_bit_cast(int, v); int r;
    switch (ctrl_sel) { case 1: r = __builtin_amdgcn_update_dpp(0, iv, 0x111, 0xf, 0xf, true); break; case 2: r = __builtin_amdgcn_update_dpp(0, iv, 0x112, 0xf, 0xf, true); break;
                        case 4: r = __builtin_amdgcn_update_dpp(0, iv, 0x114, 0xf, 0xf, true); break; default: r = __builtin_amdgcn_update_dpp(0, iv, 0x118, 0xf, 0xf, true); break; }
    return __builtin_bit_cast(float, r); }
__device__ __forceinline__ float wave_sum_dpp(float v) {
    v += dpp_shr(v, 1); v += dpp_shr(v, 2); v += dpp_shr(v, 4); v += dpp_shr(v, 8);
    v += __builtin_bit_cast(float, __builtin_amdgcn_update_dpp(0, __builtin_bit_cast(int, v), 0x142, 0xa, 0xf, false));
    v += __builtin_bit_cast(float, __builtin_amdgcn_update_dpp(0, __builtin_bit_cast(int, v), 0x143, 0xc, 0xf, false));
    return __builtin_bit_cast(float, __builtin_amdgcn_readlane(__builtin_bit_cast(int, v), 63));
}
__device__ __forceinline__ unsigned pk4_i8(float a, float b, float c, float d) {
    const int ia = (int)fminf(fmaxf(__builtin_rintf(a), -127.f), 127.f), ib = (int)fminf(fmaxf(__builtin_rintf(b), -127.f), 127.f);
    const int ic = (int)fminf(fmaxf(__builtin_rintf(c), -127.f), 127.f), id = (int)fminf(fmaxf(__builtin_rintf(d), -127.f), 127.f);
    return (unsigned)(ia & 0xff) | ((unsigned)(ib & 0xff) << 8) | ((unsigned)(ic & 0xff) << 16) | ((unsigned)(id & 0xff) << 24);
}
__device__ __forceinline__ float wave_max_dpp(float v) {
    v = fmaxf(v, dpp_shr(v, 1)); v = fmaxf(v, dpp_shr(v, 2)); v = fmaxf(v, dpp_shr(v, 4)); v = fmaxf(v, dpp_shr(v, 8));
    v = fmaxf(v, __builtin_bit_cast(float, __builtin_amdgcn_update_dpp(0, __builtin_bit_cast(int, v), 0x142, 0xa, 0xf, false)));
    v = fmaxf(v, __builtin_bit_cast(float, __builtin_amdgcn_update_dpp(0, __builtin_bit_cast(int, v), 0x143, 0xc, 0xf, false)));
    return __builtin_bit_cast(float, __builtin_amdgcn_readlane(__builtin_bit_cast(int, v), 63));
}
__device__ __forceinline__ float half_max_dpp(float v, bool hi) {
    v = fmaxf(v, dpp_shr(v, 1)); v = fmaxf(v, dpp_shr(v, 2)); v = fmaxf(v, dpp_shr(v, 4)); v = fmaxf(v, dpp_shr(v, 8));
    v = fmaxf(v, __builtin_bit_cast(float, __builtin_amdgcn_update_dpp(0, __builtin_bit_cast(int, v), 0x142, 0xa, 0xf, false)));
    const float s0 = __builtin_bit_cast(float, __builtin_amdgcn_readlane(__builtin_bit_cast(int, v), 31)), s1 = __builtin_bit_cast(float, __builtin_amdgcn_readlane(__builtin_bit_cast(int, v), 63));
    return hi ? s1 : s0;
}
__device__ __forceinline__ float wave_max(float v) { const int ln = lane_id_now();
#pragma unroll
    for (int o = 1; o < 64; o <<= 1) v = fmaxf(v, shx(v, o, ln));
    return v;
}
__device__ __forceinline__ int wave_min_i(int v) { const int ln = lane_id_now();
#pragma unroll
    for (int o = 1; o < 64; o <<= 1) { const int t = shxi(v, o, ln); v = t < v ? t : v; }
    return v;
}
__device__ __forceinline__ float fast_sigmoid(float x) { return __builtin_amdgcn_rcpf(1.0f + __expf(-x)); }
#define LDS_WAIT() asm volatile("s_waitcnt lgkmcnt(0)" ::: "memory")
#define VM_WAIT() asm volatile("s_waitcnt vmcnt(0)" ::: "memory")

#define XB_TMO      128
#define XB_XCNT(j)  (256  + 64 * (j))
#define XB_XSUB(j)  (1280 + 64 * (j))
#define XB_XGEN(j)  (2304 + 64 * (j))
#define XB_TOP      3328
#define XB_TOPGEN   3392
#define XCD_BAR_WORDS 3456
#define XB_SPIN_CAP (1u << 22)
__device__ __forceinline__ unsigned xb_ld(unsigned* p)              { return __hip_atomic_load(p, __ATOMIC_RELAXED, __HIP_MEMORY_SCOPE_AGENT); }
__device__ __forceinline__ unsigned xb_add(unsigned* p, unsigned v) { return __hip_atomic_fetch_add(p, v, __ATOMIC_RELAXED, __HIP_MEMORY_SCOPE_AGENT); }
__device__ __forceinline__ unsigned xb_xcc_id() { return (unsigned)__builtin_amdgcn_s_getreg((3 << 11) | 20) & 0xFu; }
#define XB_SPIN(cond, bar) do { unsigned _sp = 0; while (cond) { __builtin_amdgcn_s_sleep(1); \
    if ((++_sp & 255u) == 0u) { if (xb_ld(&(bar)[XB_TMO])) break; if (_sp > XB_SPIN_CAP) { atomicAdd(&(bar)[XB_TMO], 1u); break; } } } } while (0)
struct XcdBarrier { unsigned* bar; unsigned x; volatile LAS unsigned* st; };
__device__ __forceinline__ XcdBarrier xcd_barrier_post(unsigned* bar, volatile LAS unsigned* st) {
    XcdBarrier b; b.bar = bar; b.x = xb_xcc_id(); b.st = st;
    if (threadIdx.x == 0) (void)xb_add(&bar[XB_XCNT(b.x)], 1u);
    return b;
}
__device__ __forceinline__ void xcd_barrier_complete(unsigned* bar, unsigned x, unsigned& nloc, unsigned& nx) {
    const unsigned G = gridDim.x * gridDim.y * gridDim.z;
    unsigned sum, cnt, mine, sp = 0u;
    for (;;) {
        sum = 0u; cnt = 0u; mine = 0u;
#pragma unroll
        for (unsigned j = 0; j < 16; ++j) { const unsigned c = xb_ld(&bar[XB_XCNT(j)]); sum += c; cnt += (c > 0u) ? 1u : 0u; mine = (j == x) ? c : mine; }
        if (sum == G) break;
        __builtin_amdgcn_s_sleep(1);
        if ((++sp & 255u) == 0u) { if (xb_ld(&bar[XB_TMO])) break; if (sp > XB_SPIN_CAP) { atomicAdd(&bar[XB_TMO], 1u); break; } }
    }
    nloc = mine > 0u ? mine : 1u; nx = cnt > 0u ? cnt : 1u;
}
__device__ __forceinline__ void xcd_barrier(const XcdBarrier& b, const bool t0) {
    asm volatile("s_waitcnt vmcnt(0)" ::: "memory");
    __syncthreads();
    if (t0) {
        unsigned* bar = b.bar;
        __builtin_amdgcn_s_waitcnt(0);
        unsigned nloc = b.st[0], nx = b.st[1];
        if (nloc == 0u) { xcd_barrier_complete(bar, b.x, nloc, nx); b.st[0] = nloc; b.st[1] = nx; }
        const unsigned old = xb_add(&bar[XB_XSUB(b.x)], 1u);
        const unsigned gen = old / nloc;
        if (old + 1u == (gen + 1u) * nloc) {
            __builtin_amdgcn_fence(__ATOMIC_RELEASE, "agent");
            asm volatile("s_waitcnt vmcnt(0)" ::: "memory");
            const unsigned og = xb_add(&bar[XB_TOP], 1u);
            const unsigned tg = og / nx;
            if (og + 1u == (tg + 1u) * nx) xb_add(&bar[XB_TOPGEN], 1u);
            else XB_SPIN(xb_ld(&bar[XB_TOPGEN]) == tg, bar);
            __builtin_amdgcn_fence(__ATOMIC_ACQUIRE, "agent");
            xb_add(&bar[XB_XGEN(b.x)], 1u);
            asm volatile("s_waitcnt vmcnt(0)" ::: "memory");
        } else {
            XB_SPIN(xb_ld(&bar[XB_XGEN(b.x)]) == gen, bar);
            __builtin_amdgcn_fence(__ATOMIC_ACQUIRE, "agent");
            asm volatile("s_waitcnt vmcnt(0)" ::: "memory");
        }
    }
    __syncthreads();
}

namespace pg8 {
constexpr int BM = 256, BK = 64, HALF = 128, HTB = HALF * BK * 2, NXCD = 8, WGM = 8;
#if LDS_FULLLINE
__device__ __forceinline__ int lds_byte(int r, int c) { return r * 128 + ((((c >> 3) ^ (r >> 1)) & 7) << 4) + (c & 7) * 2; }
__device__ __forceinline__ void stage_rc(int b, int& R, int& C) { const int p = b >> 10, L = (b & 1023) >> 4; R = 8 * p + (L >> 3); C = (((L & 7) ^ (R >> 1)) & 7) * 8; }
#else
__device__ __forceinline__ int lds_byte(int r, int c) { const int st = (r >> 4) * 2 + (c >> 5), rr = r & 15, cc = c & 31, ob = rr * 64 + cc * 2; return st * 1024 + (ob ^ (((ob >> 9) & 1) << 5)); }
__device__ __forceinline__ void stage_rc(int b, int& R, int& C) { const int st = b / 1024, sb = b % 1024, swz = sb ^ (((sb >> 9) & 1) << 5); R = (st >> 1) * 16 + swz / 64; C = (st & 1) * 32 + (swz % 64) / 2; }
#endif
__device__ __forceinline__ int perm32(int rho) { const int n = rho >> 4, i = rho & 15; return 8 * (i >> 2) + 4 * n + (i & 3); }

struct Unit { int pm, pn, e, cnt, ord; };

__device__ __forceinline__ bool static_next(int i, int G, int c, int nM, int nN, Unit& u) {
    const int nwg = nM * nN; const long L = (long)i * G + c; if (L >= nwg) return false;
    int wgid = (int)L; { const int q = nwg / NXCD, r = nwg % NXCD, xcd = wgid % NXCD, off = wgid / NXCD; wgid = (xcd < r ? xcd * (q + 1) : r * (q + 1) + (xcd - r) * q) + off; }
    const int nig = WGM * nN, gid = wgid / nig, fm = gid * WGM, gsz = (nM - fm) < WGM ? (nM - fm) : WGM;
    u.pm = fm + ((wgid % nig) % gsz); u.pn = (wgid % nig) / gsz; u.e = 0; u.cnt = 256; return true;
}

template <class P>
__device__ __forceinline__ void gemm_phase(LAS unsigned char* lds, const P& pb, const int tid, const bool skip_epi = false) {
    const int wid = __builtin_amdgcn_readfirstlane(tid >> 6), lane = tid & 63, wr = wid >> 2, wc = wid & 3, fr = lane & 15, fq = lane >> 4;
    const int nt = pb.nt;
    unsigned voffB0[2], voffB1[2];
#pragma unroll
    for (int i = 0; i < 2; ++i) { int R, C; stage_rc(tid * 16 + i * 8192, R, C);
        int r0, r1;
        if constexpr (P::PERM16) { const int w = (R >> 5) & 3, n = (R >> 4) & 1, ii = R & 15; r0 = 64 * w + 16 * (ii >> 2) + 4 * n + (ii & 3); r1 = r0 + 8; }
        else { const int Rb = P::PERM ? ((R & ~31) + perm32(R & 31)) : R; r0 = Rb; r1 = Rb + HALF; }
        voffB0[i] = (unsigned)(r0 * pb.ldb + C) * 2u; voffB1[i] = (unsigned)(r1 * pb.ldb + C) * 2u; }
    const size_t kstep = (size_t)(BK * 2);
    const size_t kstepB = P::FP6B ? (size_t)24576 : kstep;
    const size_t kstepA = P::FP6A ? (size_t)P::KSTEPA : kstep;
    const int arow6 = wr * 64 + fr;
    const unsigned a6o0 = (unsigned)(wid * 1024 + lane * 16), a6o1 = (unsigned)(8192 + wid * 512 + (lane & 31) * 16), a6o2 = (unsigned)(24576 + wid * 64 + (lane & 15) * 4);
    const int aoff16 = (arow6 * 4 + (fq ^ ((0 - (arow6 >> 2)) & 3))) * 16, aoff8 = 8192 + (arow6 * 4 + (fq ^ (2 * ((arow6 >> 3) & 1)))) * 8;
    int aoff8m[4] = {aoff8, aoff8 + 512, aoff8 + 1024, aoff8 + 1536}; asm volatile("" : "+v"(aoff8m[1]), "+v"(aoff8m[2]), "+v"(aoff8m[3]));
    unsigned voffB6[3];
#pragma unroll
    for (int i = 0; i < 3; ++i) voffB6[i] = (unsigned)((wid * 3 + i) * 1024 + lane * 16);
    const int brow6 = wc * 32 + fr;
    const int boff16 = (brow6 * 4 + (fq ^ ((0 - (brow6 >> 2)) & 3))) * 16, boff8 = 8192 + (brow6 * 4 + (fq ^ (2 * ((brow6 >> 3) & 1)))) * 8;
    int boff8b = boff8 + 512; asm volatile("" : "+v"(boff8b));
    const unsigned ldsw = (unsigned)wid * 1024u;
    const int aoff = lds_byte(wr * 64 + fr, fq * 8), boff = lds_byte(wc * 32 + fr, fq * 8);
    const int aoff1 = lds_byte(wr * 64 + fr, 32 + fq * 8) - aoff, boff1 = lds_byte(wc * 32 + fr, 32 + fq * 8) - boff;
#define PG8_SA(b, h) (((b) * 2 + (h)) * HTB)
#define PG8_SB(b, h) ((4 + (b) * 2 + (h)) * HTB)
#define PG8_STAGE(bufoff, gbase, voff) do { _Pragma("unroll") for (int _i = 0; _i < 2; ++_i) \
        __builtin_amdgcn_global_load_lds((const unsigned*)((const char*)(gbase) + (voff)[_i]), (LAS unsigned*)(lds + (bufoff) + ldsw + _i * 8192), 16, 0, 0); } while (0)
#define PG8_LDA(dst, b, h) do { _Pragma("unroll") for (int m = 0; m < 4; ++m) _Pragma("unroll") for (int k = 0; k < 2; ++k) dst[m][k] = *(const LAS bf16x8*)(lds + PG8_SA(b, h) + aoff + m * 2048 + k * aoff1); } while (0)
#define PG8_STAGEB6(b, gbase, v6) do { _Pragma("unroll") for (int _i = 0; _i < 3; ++_i) \
        __builtin_amdgcn_global_load_lds((const unsigned*)((const char*)(gbase) + (v6)[_i]), (LAS unsigned*)(lds + PG8_SB(b, 0) + (wid >> 2) * HTB + ((wid & 3) * 3 + _i) * 1024), 16, 0, 0); } while (0)
#define PG8_STAGEBX(b, gbase, v0_, v1_, v6_) do { if constexpr (P::FP6B) { PG8_STAGEB6(b, gbase, v6_); } else { PG8_STAGE(PG8_SB(b, 0), gbase, v0_); PG8_STAGE(PG8_SB(b, 1), gbase, v1_); } } while (0)
#define PG8_STAGEB(b, gbase) PG8_STAGEBX(b, gbase, voffB0, voffB1, voffB6)
#define PG8_STAGEA(bufoff, gbase, voff, h_) do { if constexpr (P::FP6A && !P::GATHER) {     \
        __builtin_amdgcn_global_load_lds((const unsigned*)((const char*)(gbase) + (h_) * 12288 + a6o0), (LAS unsigned*)(lds + (bufoff) + ldsw), 16, 0, 0); \
        if (lane < 32) __builtin_amdgcn_global_load_lds((const unsigned*)((const char*)(gbase) + (h_) * 12288 + a6o1), (LAS unsigned*)(lds + (bufoff) + 8192 + (ldsw >> 1)), 16, 0, 0); \
        if constexpr (P::ASCALE) { if (lane < 16) __builtin_amdgcn_global_load_lds((const unsigned*)((const char*)(gbase) + (h_) * 512 + a6o2), (LAS unsigned*)(lds + (bufoff) + 12288 + (ldsw >> 4)), 4, 0, 0); } \
    } else if constexpr (P::FP6A) { \
        __builtin_amdgcn_global_load_lds((const unsigned*)((const char*)(gbase) + (voff)[0]), (LAS unsigned*)(lds + (bufoff) + ldsw), 16, 0, 0); \
        if (lane < 32) __builtin_amdgcn_global_load_lds((const unsigned*)((const char*)(gbase) + (voff)[1]), (LAS unsigned*)(lds + (bufoff) + 8192 + (ldsw >> 1)), 16, 0, 0); \
    } else { PG8_STAGE(bufoff, gbase, voff); } } while (0)
#define PG8_LDA6(dst, b, h) do { _Pragma("unroll") for (int m = 0; m < 4; ++m) { const u32x4 lo_ = *(const LAS u32x4*)(lds + PG8_SA(b, h) + aoff16 + m * 1024); const u32x2 hi_ = *(const LAS u32x2*)(lds + PG8_SA(b, h) + aoff8m[m]); \
        dst[m] = (v8i){(int)lo_.x, (int)lo_.y, (int)lo_.z, (int)lo_.w, (int)hi_.x, (int)hi_.y, 0, 0}; } } while (0)
#define PG8_LDAX(b, h) do { if constexpr (P::FP6A) { PG8_LDA6(At6, b, h); \
        if constexpr (P::ASCALE) { _Pragma("unroll") for (int m = 0; m < 4; ++m) asc[m] = (int)*(const LAS unsigned char*)(lds + PG8_SA(b, h) + 12288 + (arow6 + 16 * m) * 4 + fq); } } \
    else { PG8_LDA(At, b, h); } } while (0)
#define PG8_LDB6(dst, b, h) do { _Pragma("unroll") for (int n = 0; n < 2; ++n) { const u32x4 lo_ = *(const LAS u32x4*)(lds + PG8_SB(b, h) + boff16 + n * 1024); const u32x2 hi_ = *(const LAS u32x2*)(lds + PG8_SB(b, h) + (n ? boff8b : boff8)); \
        dst[n] = (v8i){(int)lo_.x, (int)lo_.y, (int)lo_.z, (int)lo_.w, (int)hi_.x, (int)hi_.y, 0, 0}; } } while (0)
#define PG8_LDB(dst, b, h) do { _Pragma("unroll") for (int n = 0; n < 2; ++n) _Pragma("unroll") for (int k = 0; k < 2; ++k) dst[n][k] = *(const LAS bf16x8*)(lds + PG8_SB(b, h) + boff + n * 2048 + k * boff1); } while (0)
#define PG8_CAT(x) __builtin_shufflevector(__builtin_bit_cast(v4i, (x)[0]), __builtin_bit_cast(v4i, (x)[1]), 0, 1, 2, 3, 4, 5, 6, 7)
#define PG8_MMA(ai, bj, At, Bt) do { __builtin_amdgcn_s_setprio(1); \
        if constexpr (P::INT8) { _Pragma("unroll") for (int m = 0; m < 4; ++m) _Pragma("unroll") for (int n = 0; n < 2; ++n) _Pragma("unroll") for (int k = 0; k < 2; ++k) \
            acc[ai][bj][m][n] = __builtin_bit_cast(f32x4, __builtin_amdgcn_mfma_i32_16x16x64_i8(__builtin_bit_cast(v4i, Bt[n][k]), __builtin_bit_cast(v4i, At[m][k]), __builtin_bit_cast(v4i, acc[ai][bj][m][n]), 0, 0, 0)); } \
        else if constexpr (P::FP8) { _Pragma("unroll") for (int m = 0; m < 4; ++m) _Pragma("unroll") for (int n = 0; n < 2; ++n) \
            acc[ai][bj][m][n] = __builtin_amdgcn_mfma_scale_f32_16x16x128_f8f6f4(PG8_CAT(Bt[n]), PG8_CAT(At[m]), acc[ai][bj][m][n], 0, 0, 0, 0, 0, 0); } \
        else { _Pragma("unroll") for (int m = 0; m < 4; ++m) _Pragma("unroll") for (int n = 0; n < 2; ++n) _Pragma("unroll") for (int k = 0; k < 2; ++k) \
            acc[ai][bj][m][n] = __builtin_amdgcn_mfma_f32_16x16x32_bf16(Bt[n][k], At[m][k], acc[ai][bj][m][n], 0, 0, 0); } \
        __builtin_amdgcn_s_setprio(0); } while (0)
#define PG8_MMA6(ai, bj, At, B6) do { __builtin_amdgcn_s_setprio(1); \
        _Pragma("unroll") for (int m = 0; m < 4; ++m) _Pragma("unroll") for (int n = 0; n < 2; ++n) \
            acc[ai][bj][m][n] = __builtin_amdgcn_mfma_scale_f32_16x16x128_f8f6f4(B6[n], PG8_CAT(At[m]), acc[ai][bj][m][n], 2, 0, 0, 0, 0, 0); \
        __builtin_amdgcn_s_setprio(0); } while (0)
#define PG8_MMA66(ai, bj, A6, B6) do { __builtin_amdgcn_s_setprio(1); \
        _Pragma("unroll") for (int m = 0; m < 4; ++m) _Pragma("unroll") for (int n = 0; n < 2; ++n) \
            acc[ai][bj][m][n] = __builtin_amdgcn_mfma_scale_f32_16x16x128_f8f6f4(B6[n], A6[m], acc[ai][bj][m][n], 2, 2, 0, 0, 0, 0); \
        __builtin_amdgcn_s_setprio(0); } while (0)
#define PG8_MMA66S(ai, bj, A6, B6) do { __builtin_amdgcn_s_setprio(1); \
        _Pragma("unroll") for (int m = 0; m < 4; ++m) _Pragma("unroll") for (int n = 0; n < 2; ++n) \
            { const v6i w6_ = __builtin_shufflevector(B6[n], B6[n], 0, 1, 2, 3, 4, 5), x6_ = __builtin_shufflevector(A6[m], A6[m], 0, 1, 2, 3, 4, 5); \
              asm("s_nop 3\n\tv_mfma_scale_f32_16x16x128_f8f6f4 %0, %1, %2, %0, %3, %4 op_sel_hi:[0,0,0] cbsz:2 blgp:2" : "+v"(acc[ai][bj][m][n]) : "v"(w6_), "v"(x6_), "v"(one8), "v"(asc[m])); } \
        __builtin_amdgcn_s_setprio(0); } while (0)
#define PG8_WAIT_V(n) asm volatile("s_waitcnt vmcnt(" #n ")" ::: "memory")
#define PG8_WAIT_VK do { if constexpr (P::ASCALE) PG8_WAIT_V(9); else if constexpr (P::FP6B) PG8_WAIT_V(7); else PG8_WAIT_V(8); } while (0)
#define PG8_MMAB(ai) do { if constexpr (P::ASCALE) { PG8_MMA66S(ai, 0, At6, B60); PG8_MMA66S(ai, 1, At6, B61); } else if constexpr (P::FP6A) { PG8_MMA66(ai, 0, At6, B60); PG8_MMA66(ai, 1, At6, B61); } else if constexpr (P::FP6B) { PG8_MMA6(ai, 0, At, B60); PG8_MMA6(ai, 1, At, B61); } else { PG8_MMA(ai, 0, At, B0); PG8_MMA(ai, 1, At, B1); } } while (0)
#define PG8_WAIT_L(n) asm volatile("s_waitcnt lgkmcnt(" #n ")" ::: "memory")
#define PG8_BAR __builtin_amdgcn_s_barrier()
#define PG8_SCHED __builtin_amdgcn_sched_barrier(0)
    Unit cur, nxt; int ui = 0;
    if (!pb.next(0, cur)) return;
    f32x4 acc[2][2][4][2];
#pragma unroll
    for (int a = 0; a < 2; ++a)
#pragma unroll
        for (int b = 0; b < 2; ++b)
#pragma unroll
            for (int m = 0; m < 4; ++m)
#pragma unroll
                for (int n = 0; n < 2; ++n) acc[a][b][m][n] = (f32x4){0.f, 0.f, 0.f, 0.f};
    bf16x8 At[4][2], B0[2][2], B1[2][2]; v8i B60[2], B61[2], At6[4]; int asc[4] = {0, 0, 0, 0}; int one8 = 127; asm volatile("" : "+v"(one8));
    unsigned vAc[2][2], vAn[2][2];
    if constexpr (P::META) { if (wid == 0) pb.meta(cur, lane); }
    pb.a_voff(cur, vAc, tid);
    const char* cA = pb.a_ptr(cur); const char* cB = pb.b_ptr(cur);
    PG8_STAGEB(0, cB); PG8_STAGEA(PG8_SA(0, 0), cA, vAc[0], 0); PG8_STAGEA(PG8_SA(0, 1), cA, vAc[1], 1);
    if (wr == 1) PG8_BAR;
    if constexpr (P::ASCALE) PG8_WAIT_V(3); else PG8_WAIT_V(2);
    PG8_BAR;
    PG8_STAGEB(1, cB + kstepB); PG8_STAGEA(PG8_SA(1, 0), cA + kstepA, vAc[0], 0);
    if constexpr (P::ASCALE) PG8_WAIT_V(6); else if constexpr (P::FP6B) PG8_WAIT_V(5); else PG8_WAIT_V(6);
    PG8_BAR;
    for (;;) {
        const bool has_next = pb.next(ui + 1, nxt);
        const char* nA = has_next ? pb.a_ptr(nxt) : cA; const char* nB = has_next ? pb.b_ptr(nxt) : cB;
        if constexpr (P::META) { if (has_next && wid == 0) pb.meta(nxt, lane_id_now()); }
        if (has_next) { if constexpr (!P::META) pb.a_voff(nxt, vAn, tid);
            else if constexpr (!P::GATHER) {
#pragma unroll
                for (int h = 0; h < 2; ++h)
#pragma unroll
                    for (int i = 0; i < 2; ++i) vAn[h][i] = vAc[h][i]; } }
        else {
#pragma unroll
            for (int h = 0; h < 2; ++h)
#pragma unroll
                for (int i = 0; i < 2; ++i) vAn[h][i] = (unsigned)(lane * 16); }
        const unsigned zm = has_next ? 0xffffffffu : 0u;
        for (int t = 0; t < nt; t += 2) {
            const bool last = (t == nt - 2);
            const char* a1 = cA + (size_t)(t + 1) * kstepA;
            const char* a2 = last ? nA : cA + (size_t)(t + 2) * kstepA; const char* b2 = last ? nB : cB + (size_t)(t + 2) * kstepB;
            const char* a3 = a2 + kstepA; const char* b3 = b2 + kstepB;
            unsigned vb0[2], vb1[2], vb6[3]; { const unsigned z = last ? zm : 0xffffffffu; const unsigned zl = (unsigned)(lane * 16) & ~z; vb0[0] = (voffB0[0] & z) | zl; vb0[1] = (voffB0[1] & z) | zl; vb1[0] = (voffB1[0] & z) | zl; vb1[1] = (voffB1[1] & z) | zl;
                vb6[0] = (voffB6[0] & z) | zl; vb6[1] = (voffB6[1] & z) | zl; vb6[2] = (voffB6[2] & z) | zl; }
            if (P::MID >= 0 && t == P::MID) pb.mid(acc, cur, wr, wc, fr, fq);
            if constexpr (P::GATHER) { if (last && has_next) pb.a_voff_lds(nxt, vAn, wid * 64 + lane_id_now()); }
            if constexpr (P::FP6B) { PG8_LDB6(B60, 0, 0); PG8_LDB6(B61, 0, 1); } else { PG8_LDB(B0, 0, 0); PG8_LDB(B1, 0, 1); } PG8_SCHED; PG8_LDAX(0, 0); PG8_STAGEA(PG8_SA(1, 1), a1, vAc[1], 1);
            if (last) {
#pragma unroll
                for (int h = 0; h < 2; ++h)
#pragma unroll
                    for (int i = 0; i < 2; ++i) vAc[h][i] = vAn[h][i]; }
            PG8_WAIT_VK; PG8_WAIT_L(0); PG8_BAR; PG8_MMAB(0); PG8_BAR; PG8_SCHED;
            PG8_LDAX(0, 1); PG8_STAGEBX(0, b2, vb0, vb1, vb6); PG8_STAGEA(PG8_SA(0, 0), a2, vAc[0], 0);
            PG8_WAIT_VK; PG8_WAIT_L(0); PG8_BAR; PG8_MMAB(1); PG8_BAR; PG8_SCHED;
            if constexpr (P::FP6B) { PG8_LDB6(B60, 1, 0); PG8_LDB6(B61, 1, 1); } else { PG8_LDB(B0, 1, 0); PG8_LDB(B1, 1, 1); } PG8_SCHED; PG8_LDAX(1, 0); PG8_STAGEA(PG8_SA(0, 1), a2, vAc[1], 1);
            PG8_WAIT_VK; PG8_WAIT_L(0); PG8_BAR; PG8_MMAB(0); PG8_BAR; PG8_SCHED;
            PG8_LDAX(1, 1); PG8_STAGEBX(1, b3, vb0, vb1, vb6); PG8_STAGEA(PG8_SA(1, 0), a3, vAc[0], 0);
            PG8_WAIT_VK; PG8_WAIT_L(0); PG8_BAR; PG8_MMAB(1); PG8_BAR; PG8_SCHED;
        }
        if constexpr (P::ASCALE) asm volatile("s_nop 15\n\ts_nop 15" ::: "memory");
        if (wr == 0) PG8_BAR;
        if constexpr (!P::AFTER_DRAIN) { if (!skip_epi) pb.epi(acc, cur, wr, wc, fr, fq); }
        if (!has_next) break;
#pragma unroll
        for (int a = 0; a < 2; ++a)
#pragma unroll
            for (int b = 0; b < 2; ++b)
#pragma unroll
                for (int m = 0; m < 4; ++m)
#pragma unroll
                    for (int n = 0; n < 2; ++n) acc[a][b][m][n] = (f32x4){0.f, 0.f, 0.f, 0.f};
        cur = nxt; cA = nA; cB = nB; ++ui;
        if (wr == 1) PG8_BAR;
    }
    PG8_WAIT_V(0);
    PG8_BAR;
    if constexpr (P::AFTER_DRAIN) { if (!skip_epi) pb.epi(acc, cur, wr, wc, fr, fq); }
#undef PG8_SA
#undef PG8_SB
#undef PG8_STAGE
#undef PG8_STAGEB
#undef PG8_STAGEB6
#undef PG8_STAGEA
#undef PG8_LDA6
#undef PG8_LDAX
#undef PG8_MMA66
#undef PG8_MMA66S
#undef PG8_STAGEBX
#undef PG8_LDB6
#undef PG8_MMA6
#undef PG8_MMAB
#undef PG8_WAIT_VK
#undef PG8_LDA
#undef PG8_LDB
#undef PG8_MMA
#undef PG8_CAT
#undef PG8_WAIT_V
#undef PG8_WAIT_L
#undef PG8_BAR
#undef PG8_SCHED
}

template <class P>
__device__ __forceinline__ void gemm_phase6(LAS unsigned char* lds, const P& pb, const int tid, const bool skip_epi = false) {
    static_assert(P::FP6A && P::FP6B && P::META, "fp6 x fp6 grouped policies only");
    const int wid = __builtin_amdgcn_readfirstlane(tid >> 6), lane = tid & 63, wr = wid >> 2, wc = wid & 3, fr = lane & 15, fq = lane >> 4;
    constexpr int STG = 50176, A1O = 12800, BO = 25600, NT = 8;
    constexpr size_t kstepA = (size_t)P::KSTEPA, kstepB = 24576;
    unsigned voffB6[3];
#pragma unroll
    for (int i = 0; i < 3; ++i) voffB6[i] = (unsigned)((wid * 3 + i) * 1024 + lane * 16);
    const int brow6 = wc * 32 + fr, arow6 = wr * 64 + fr;
    const int boff16 = BO + (brow6 * 4 + (fq ^ ((0 - (brow6 >> 2)) & 3))) * 16, boff8 = BO + 8192 + (brow6 * 4 + (fq ^ (2 * ((brow6 >> 3) & 1)))) * 8;
    const int aoff16 = (arow6 * 4 + (fq ^ ((0 - (arow6 >> 2)) & 3))) * 16, aoff8 = 8192 + (arow6 * 4 + (fq ^ (2 * ((arow6 >> 3) & 1)))) * 8, aoffs = 12288 + arow6 * 4 + fq;
    const unsigned a6o0 = (unsigned)(wid * 1024 + lane * 16), a6o1 = (unsigned)(8192 + wid * 512 + (lane & 31) * 16), a6o2 = (unsigned)(24576 + wid * 64 + (lane & 15) * 4);
    const unsigned ldsw = (unsigned)wid * 1024u;
#define G6_STAGE(SO, ap, bp, vA, vB) do { \
        _Pragma("unroll") for (int _i = 0; _i < 3; ++_i) __builtin_amdgcn_global_load_lds((const unsigned*)((const char*)(bp) + (vB)[_i]), (LAS unsigned*)(lds + (SO) + BO + (wid >> 2) * 12288 + ((wid & 3) * 3 + _i) * 1024), 16, 0, 0); \
        _Pragma("unroll") for (int _h = 0; _h < 2; ++_h) { \
            if constexpr (P::GATHER) { \
                __builtin_amdgcn_global_load_lds((const unsigned*)((const char*)(ap) + (vA)[_h][0]), (LAS unsigned*)(lds + (SO) + _h * A1O + ldsw), 16, 0, 0); \
                if (lane < 32) __builtin_amdgcn_global_load_lds((const unsigned*)((const char*)(ap) + (vA)[_h][1]), (LAS unsigned*)(lds + (SO) + _h * A1O + 8192 + (ldsw >> 1)), 16, 0, 0); \
            } else { \
                __builtin_amdgcn_global_load_lds((const unsigned*)((const char*)(ap) + _h * 12288 + a6o0), (LAS unsigned*)(lds + (SO) + _h * A1O + ldsw), 16, 0, 0); \
                if (lane < 32) __builtin_amdgcn_global_load_lds((const unsigned*)((const char*)(ap) + _h * 12288 + a6o1), (LAS unsigned*)(lds + (SO) + _h * A1O + 8192 + (ldsw >> 1)), 16, 0, 0); \
                if constexpr (P::ASCALE) { if (lane < 16) __builtin_amdgcn_global_load_lds((const unsigned*)((const char*)(ap) + _h * 512 + a6o2), (LAS unsigned*)(lds + (SO) + _h * A1O + 12288 + (ldsw >> 4)), 4, 0, 0); } \
            } } } while (0)
#define G6_LDB(dst, SO, h) do { _Pragma("unroll") for (int n = 0; n < 2; ++n) { const u32x4 lo_ = *(const LAS u32x4*)(lds + (SO) + (h) * 12288 + boff16 + n * 1024); const u32x2 hi_ = *(const LAS u32x2*)(lds + (SO) + (h) * 12288 + boff8 + n * 512); \
        dst[n] = (v8i){(int)lo_.x, (int)lo_.y, (int)lo_.z, (int)lo_.w, (int)hi_.x, (int)hi_.y, 0, 0}; } } while (0)
#define G6_LDA(SO, h) do { _Pragma("unroll") for (int m = 0; m < 4; ++m) { const u32x4 lo_ = *(const LAS u32x4*)(lds + (SO) + (h) * A1O + aoff16 + m * 1024); const u32x2 hi_ = *(const LAS u32x2*)(lds + (SO) + (h) * A1O + aoff8 + m * 512); \
        At6[m] = (v8i){(int)lo_.x, (int)lo_.y, (int)lo_.z, (int)lo_.w, (int)hi_.x, (int)hi_.y, 0, 0}; \
        if constexpr (P::ASCALE) asc[m] = (int)*(const LAS unsigned char*)(lds + (SO) + (h) * A1O + aoffs + m * 64); } } while (0)
#define G6_MMA(ai, bj, B6) do { __builtin_amdgcn_s_setprio(1); \
        _Pragma("unroll") for (int m = 0; m < 4; ++m) _Pragma("unroll") for (int n = 0; n < 2; ++n) { \
            if constexpr (P::ASCALE) { const v6i w6_ = __builtin_shufflevector(B6[n], B6[n], 0, 1, 2, 3, 4, 5), x6_ = __builtin_shufflevector(At6[m], At6[m], 0, 1, 2, 3, 4, 5); \
                asm("s_nop 3\n\tv_mfma_scale_f32_16x16x128_f8f6f4 %0, %1, %2, %0, %3, %4 op_sel_hi:[0,0,0] cbsz:2 blgp:2" : "+v"(acc[ai][bj][m][n]) : "v"(w6_), "v"(x6_), "v"(one8), "v"(asc[m])); } \
            else acc[ai][bj][m][n] = __builtin_amdgcn_mfma_scale_f32_16x16x128_f8f6f4(B6[n], At6[m], acc[ai][bj][m][n], 2, 2, 0, 0, 0, 0); } \
        __builtin_amdgcn_s_setprio(0); } while (0)
#define G6_WAIT_V(n) asm volatile("s_waitcnt vmcnt(" #n ")" ::: "memory")
#define G6_WAIT_L asm volatile("s_waitcnt lgkmcnt(0)" ::: "memory")
#define G6_BAR __builtin_amdgcn_s_barrier()
#define G6_SCHED __builtin_amdgcn_sched_barrier(0)
    Unit cur, nxt; int ui = 0;
    if (!pb.next(0, cur)) return;
    f32x4 acc[2][2][4][2];
#pragma unroll
    for (int a = 0; a < 2; ++a)
#pragma unroll
        for (int b = 0; b < 2; ++b)
#pragma unroll
            for (int m = 0; m < 4; ++m)
#pragma unroll
                for (int n = 0; n < 2; ++n) acc[a][b][m][n] = (f32x4){0.f, 0.f, 0.f, 0.f};
    v8i B60[2], B61[2], At6[4]; int asc[4] = {0, 0, 0, 0}; int one8 = 127; asm volatile("" : "+v"(one8));
    unsigned vAc[2][2], vAn[2][2];
    if (wid == 0) pb.meta(cur, lane);
    pb.a_voff(cur, vAc, tid);
#pragma unroll
    for (int h = 0; h < 2; ++h)
#pragma unroll
        for (int i = 0; i < 2; ++i) vAn[h][i] = vAc[h][i];
    const char* cA = pb.a_ptr(cur); const char* cB = pb.b_ptr(cur);
    G6_STAGE(0, cA, cB, vAc, voffB6); G6_STAGE(STG, cA + kstepA, cB + kstepB, vAc, voffB6);
    if (wr == 1) G6_BAR;
    G6_WAIT_V(0); G6_BAR; G6_BAR;
    int buf = 0;
    for (;;) {
        const bool has_next = pb.next(ui + 1, nxt);
        const char* nA = has_next ? pb.a_ptr(nxt) : cA; const char* nB = has_next ? pb.b_ptr(nxt) : cB;
        if (has_next && wid == 0) pb.meta(nxt, lane_id_now());
        const unsigned zm = has_next ? 0xffffffffu : 0u, zl = (unsigned)(lane_id_now() * 16) & ~zm;
#pragma nounroll
        for (int t = 0; t < NT; ++t) {
            const unsigned SO = (unsigned)buf * STG, SO2 = (unsigned)(buf == 0 ? 2 : buf - 1) * STG;
            const bool nx = t >= NT - 2;
            if (t == NT - 2) { if constexpr (P::GATHER) { if (has_next) pb.a_voff_lds(nxt, vAn, wid * 64 + lane_id_now()); }
#pragma unroll
                for (int h = 0; h < 2; ++h)
#pragma unroll
                    for (int i = 0; i < 2; ++i) vAc[h][i] = has_next ? vAn[h][i] : (unsigned)(lane_id_now() * 16); }
            const char* aS = nx ? nA + (size_t)(t - (NT - 2)) * kstepA : cA + (size_t)(t + 2) * kstepA; const char* bS = nx ? nB + (size_t)(t - (NT - 2)) * kstepB : cB + (size_t)(t + 2) * kstepB;
            unsigned vb[3]; { const unsigned z = nx ? zm : 0xffffffffu, zz = nx ? zl : 0u; vb[0] = (voffB6[0] & z) | zz; vb[1] = (voffB6[1] & z) | zz; vb[2] = (voffB6[2] & z) | zz; }
            G6_LDB(B60, SO, 0); G6_LDB(B61, SO, 1); G6_SCHED; G6_LDA(SO, 0); G6_STAGE(SO2, aS, bS, vAc, vb);
            G6_WAIT_L; G6_BAR; G6_MMA(0, 0, B60); G6_MMA(0, 1, B61); G6_BAR; G6_SCHED;
            G6_LDA(SO, 1);
            if constexpr (P::ASCALE) G6_WAIT_V(9); else G6_WAIT_V(7);
            G6_WAIT_L; G6_BAR; G6_MMA(1, 0, B60); G6_MMA(1, 1, B61); G6_BAR; G6_SCHED;
            buf = buf == 2 ? 0 : buf + 1;
        }
        if constexpr (P::ASCALE) asm volatile("s_nop 15\n\ts_nop 15" ::: "memory");
        if (wr == 0) G6_BAR;
        if (!skip_epi) pb.epi(acc, cur, wr, wc, fr, fq);
        if (!has_next) break;
#pragma unroll
        for (int a = 0; a < 2; ++a)
#pragma unroll
            for (int b = 0; b < 2; ++b)
#pragma unroll
                for (int m = 0; m < 4; ++m)
#pragma unroll
                    for (int n = 0; n < 2; ++n) acc[a][b][m][n] = (f32x4){0.f, 0.f, 0.f, 0.f};
        cur = nxt; cA = nA; cB = nB; ++ui;
        if (wr == 1) G6_BAR;
    }
    G6_WAIT_V(0);
    G6_BAR;
#undef G6_STAGE
#undef G6_LDB
#undef G6_LDA
#undef G6_MMA
#undef G6_WAIT_V
#undef G6_WAIT_L
#undef G6_BAR
#undef G6_SCHED
}
}
using pg8::Unit;
typedef f32x4 AccT[2][2][4][2];

struct Frame {
    LAS unsigned char* lds;
    int tid, lane, wave, G, gw, ngw;
    const float* in[26];
    float* out;
    unsigned char* ws;
};
template <class T> __device__ __forceinline__ T* wsp(const Frame& F, size_t off) { return (T*)(F.ws + off); }

struct DenseBase {
    const bf16* A; const bf16* Bt; int lda, ldb, nM, nN, G, c, nt;
    __device__ __forceinline__ bool next(int i, Unit& u) const { u.ord = i; return pg8::static_next(i, G, c, nM, nN, u); }
    __device__ __forceinline__ const char* a_ptr(const Unit& u) const { return (const char*)A + (size_t)u.pm * 256 * lda * 2; }
    __device__ __forceinline__ const char* b_ptr(const Unit& u) const { return (const char*)Bt + (size_t)u.pn * 256 * ldb * 2; }
    __device__ __forceinline__ void a_voff(const Unit&, unsigned (&v)[2][2], int tid_) const {
        int tz = tid_; asm volatile("" : "+v"(tz));
#pragma unroll
        for (int i = 0; i < 2; ++i) { int R, C; pg8::stage_rc(tz * 16 + i * 8192, R, C);
#pragma unroll
            for (int h = 0; h < 2; ++h) v[h][i] = (unsigned)((h * 128 + R) * lda + C) * 2u; }
    }
    __device__ __forceinline__ void mid(AccT&, const Unit&, int, int, int, int) const {}
};
struct ProbInProj : DenseBase {
    static constexpr bool PERM = true, FP8 = false, AFTER_DRAIN = false, META = false, GATHER = false, PERM16 = false, INT8 = true, FP6B = false, FP6A = false, ASCALE = false; static constexpr int MID = -1, KSTEPA = 0;
    const float* rowsc; const float* sw; bf16* O; bf16* UB;
    __device__ __forceinline__ void epi(const AccT& acc, const Unit& u, int wr, int wc, int fr, int fq) const {
        int row0 = u.pm * 256 + wr * 64 + fr, col0 = u.pn * 256 + wc * 32 + 8 * fq; asm volatile("" : "+v"(row0), "+v"(col0));
        const bool ucols = u.pn < 2;
        f32x4 sv[2][2];
#pragma unroll
        for (int bj = 0; bj < 2; ++bj)
#pragma unroll
            for (int n = 0; n < 2; ++n) sv[bj][n] = *(const f32x4*)(sw + col0 + bj * 128 + 4 * n);
        float rsv[2][4];
#pragma unroll
        for (int ai = 0; ai < 2; ++ai)
#pragma unroll
            for (int m = 0; m < 4; ++m) rsv[ai][m] = rowsc[(unsigned)(row0 + ai * 128 + m * 16)];
#pragma unroll
        for (int ai = 0; ai < 2; ++ai)
#pragma unroll
            for (int m = 0; m < 4; ++m) { const int row = row0 + ai * 128 + m * 16; const float rs = rsv[ai][m];
#pragma unroll
                for (int bj = 0; bj < 2; ++bj) { const v4i i0 = __builtin_bit_cast(v4i, acc[ai][bj][m][0]), i1 = __builtin_bit_cast(v4i, acc[ai][bj][m][1]);
                    const f32x4 v0 = (f32x4){(float)i0[0], (float)i0[1], (float)i0[2], (float)i0[3]} * sv[bj][0] * rs, v1 = (f32x4){(float)i1[0], (float)i1[1], (float)i1[2], (float)i1[3]} * sv[bj][1] * rs;
                    u32x4 w; w.x = pk2(v0[0], v0[1]); w.y = pk2(v0[2], v0[3]); w.z = pk2(v1[0], v1[1]); w.w = pk2(v1[2], v1[3]);
                    const int col = col0 + bj * 128;
                    if (ucols) *(u32x4*)(UB + (unsigned)(((row >> 5) * NG + (col >> 4)) * UK + (row & 31) * 16 + (col & 15))) = w;
                    else *(u32x4*)(O + (unsigned)(row * INW + col)) = w; } }
    }
};

struct ProbGlu : DenseBase {
    static constexpr bool PERM = true, FP8 = false, AFTER_DRAIN = false, META = false, GATHER = false, PERM16 = false, INT8 = false, FP6B = false, FP6A = false, ASCALE = false; static constexpr int MID = -1, KSTEPA = 0;
    const bf16* Z; const float* bias; bf16* O; float* ssqp;
    __device__ __forceinline__ void epi(const AccT& acc, const Unit& u, int wr, int wc, int fr, int fq) const {
        int row0 = u.pm * 256 + wr * 64 + fr, col0 = u.pn * 256 + wc * 32 + 8 * fq; asm volatile("" : "+v"(row0), "+v"(col0));
        f32x4 bv[2][2];
#pragma unroll
        for (int bj = 0; bj < 2; ++bj)
#pragma unroll
            for (int n = 0; n < 2; ++n) bv[bj][n] = *(const f32x4*)(bias + col0 + bj * 128 + 4 * n);
#pragma unroll
        for (int ai = 0; ai < 2; ++ai)
#pragma unroll
            for (int m = 0; m < 4; ++m) { const int row = row0 + ai * 128 + m * 16; float ss = 0.f;
#pragma unroll
                for (int bj = 0; bj < 2; ++bj) {
                    const u32x4 zz = *(const u32x4*)(Z + (unsigned)(row * SSMW + col0 + bj * 128));
                    const f32x4 a0 = acc[ai][bj][m][0] + bv[bj][0], a1 = acc[ai][bj][m][1] + bv[bj][1];
                    float o[8];
                    o[0] = bflo(zz.x) * fast_sigmoid(a0[0]); o[1] = bfhi(zz.x) * fast_sigmoid(a0[1]); o[2] = bflo(zz.y) * fast_sigmoid(a0[2]); o[3] = bfhi(zz.y) * fast_sigmoid(a0[3]);
                    o[4] = bflo(zz.z) * fast_sigmoid(a1[0]); o[5] = bfhi(zz.z) * fast_sigmoid(a1[1]); o[6] = bflo(zz.w) * fast_sigmoid(a1[2]); o[7] = bfhi(zz.w) * fast_sigmoid(a1[3]);
                    if (DBG_SKIP & 2) {
#pragma unroll
                        for (int j = 0; j < 8; ++j) o[j] = 0.f; }
#pragma unroll
                    for (int j = 0; j < 8; ++j) ss += o[j] * o[j];
                    u32x4 w; w.x = pk2(o[0], o[1]); w.y = pk2(o[2], o[3]); w.z = pk2(o[4], o[5]); w.w = pk2(o[6], o[7]);
                    *(u32x4*)(O + (unsigned)(row * DM + col0 + bj * 128)) = w; }
                { const int ln = fq * 16 + fr; ss += shx(ss, 16, ln); ss += shx(ss, 32, ln); }
                if (fq == 0) ssqp[(unsigned)(row * 8 + u.pn * 4 + wc)] = ss; }
    }
};
struct ProbOutProj : DenseBase {
    static constexpr bool PERM = true, FP8 = false, AFTER_DRAIN = false, META = false, GATHER = false, PERM16 = false, INT8 = false, FP6B = false, FP6A = false, ASCALE = false; static constexpr int MID = 8, KSTEPA = 0;
    const bf16* xres; bf16* X1b; unsigned char* X1q; const LAS float* rsT;
    __device__ __forceinline__ void mid(AccT& acc, const Unit& u, int wr, int wc, int fr, int fq) const {
        const LAS float* t = rsT + (u.ord & 1) * 256 + wr * 64 + fr;
#pragma unroll
        for (int ai = 0; ai < 2; ++ai)
#pragma unroll
            for (int m = 0; m < 4; ++m) { const float rs = t[ai * 128 + m * 16];
#pragma unroll
                for (int bj = 0; bj < 2; ++bj)
#pragma unroll
                    for (int n = 0; n < 2; ++n) acc[ai][bj][m][n] *= rs; }
    }
    __device__ __forceinline__ void epi(const AccT& acc, const Unit& u, int wr, int wc, int fr, int fq) const {
        int row0 = u.pm * 256 + wr * 64 + fr, col0 = u.pn * 256 + wc * 32 + 8 * fq; asm volatile("" : "+v"(row0), "+v"(col0));
#pragma unroll
        for (int ai = 0; ai < 2; ++ai)
#pragma unroll
            for (int m = 0; m < 4; ++m) { const unsigned off = (unsigned)((row0 + ai * 128 + m * 16) * DM + col0);
#pragma unroll
                for (int bj = 0; bj < 2; ++bj) { const u32x4 xr = *(const u32x4*)(xres + off + bj * 128); const f32x4 a0 = acc[ai][bj][m][0], a1 = acc[ai][bj][m][1];
                    const float v0 = bflo(xr.x) + a0[0], v1 = bfhi(xr.x) + a0[1], v2 = bflo(xr.y) + a0[2], v3 = bfhi(xr.y) + a0[3];
                    const float v4 = bflo(xr.z) + a1[0], v5 = bfhi(xr.z) + a1[1], v6 = bflo(xr.w) + a1[2], v7 = bfhi(xr.w) + a1[3];
                    u32x4 w; w.x = pk2(v0, v1); w.y = pk2(v2, v3); w.z = pk2(v4, v5); w.w = pk2(v6, v7); *(u32x4*)(X1b + off + bj * 128) = w;
                    if (!GU_FP6A) { u32x2 q; q.x = pk4_fp8(v0, v1, v2, v3); q.y = pk4_fp8(v4, v5, v6, v7); *(u32x2*)(X1q + off + bj * 128) = q; } }
                if (m == 3) asm volatile("" ::: "memory"); }
    }
};
struct ProbSState {
    static constexpr bool PERM = false, FP8 = false, AFTER_DRAIN = true, META = false, GATHER = false, PERM16 = false, INT8 = false, FP6B = false, FP6A = false, ASCALE = false; static constexpr int MID = -1, KSTEPA = 0;
    const bf16* UB; const bf16* PZ; LAS float* Sl; int c, nt, ldb;
    __device__ __forceinline__ bool next(int i, Unit& u) const { if (i > 0 || c >= 128) return false; const int x = c & 7, j = c >> 3;
        u.pm = j & 3; u.pn = x * 4 + (j >> 2); u.e = 0; u.cnt = 256; u.ord = 0; return true; }
    __device__ __forceinline__ const char* a_ptr(const Unit& u) const { return (const char*)UB + ((size_t)u.pm * 256 * ULD + (size_t)u.pn * UK) * 2; }
    __device__ __forceinline__ const char* b_ptr(const Unit& u) const { return (const char*)PZ + ((size_t)(u.pn >> 1) * 256 * 1280 + (size_t)(u.pn & 1) * UK) * 2; }
    __device__ __forceinline__ void a_voff(const Unit&, unsigned (&v)[2][2], int tid_) const {
        int tz = tid_; asm volatile("" : "+v"(tz));
#pragma unroll
        for (int i = 0; i < 2; ++i) { int R, C; pg8::stage_rc(tz * 16 + i * 8192, R, C);
#pragma unroll
            for (int h = 0; h < 2; ++h) v[h][i] = (unsigned)((h * 128 + R) * ULD + C) * 2u; }
    }
    __device__ __forceinline__ void mid(AccT&, const Unit&, int, int, int, int) const {}
    __device__ __forceinline__ void epi(const AccT& acc, const Unit& u, int wr, int wc, int fr, int fq) const {
        const int row0 = wr * 64 + fr, comp0 = wc * 32 + 4 * fq;
#pragma unroll
        for (int ai = 0; ai < 2; ++ai)
#pragma unroll
            for (int m = 0; m < 4; ++m) { const int ch = row0 + ai * 128 + m * 16;
#pragma unroll
                for (int bj = 0; bj < 2; ++bj)
#pragma unroll
                    for (int n = 0; n < 2; ++n) if (bj == (u.pn & 1)) *(LAS f32x4*)(Sl + ch * SPITCH + comp0 + n * 16) = acc[ai][bj][m][n]; }
    }
};
struct ProbSsmOut {
    static constexpr bool PERM = true, FP8 = false, AFTER_DRAIN = false, META = false, GATHER = false, PERM16 = false, INT8 = false, FP6B = false, FP6A = false, ASCALE = false; static constexpr int MID = -1, KSTEPA = 0;
    const bf16* UB; const bf16* TZ; const float* dsk; bf16* Z; int G, c, nt, ldb;
    __device__ __forceinline__ bool next(int i, Unit& u) const { int L = i * G + c; if (L >= NG * 8) return false;
        if (G == 256) { const int x = c & 7, j = c >> 3; L = (x * 4 + (j >> 3)) * 8 + (j & 7); }
        u.e = L >> 3; u.pm = (L & 7) >> 1; u.pn = L & 1; u.cnt = 256; u.ord = i; return true; }
    __device__ __forceinline__ const char* a_ptr(const Unit& u) const { return (const char*)UB + ((size_t)u.pm * 256 * ULD + (size_t)u.e * UK) * 2; }
    __device__ __forceinline__ const char* b_ptr(const Unit& u) const { return (const char*)TZ + ((size_t)u.e * 512 + (size_t)u.pn * 256) * UK * 2; }
    __device__ __forceinline__ void a_voff(const Unit&, unsigned (&v)[2][2], int tid_) const {
        int tz = tid_; asm volatile("" : "+v"(tz));
#pragma unroll
        for (int i = 0; i < 2; ++i) { int R, C; pg8::stage_rc(tz * 16 + i * 8192, R, C);
#pragma unroll
            for (int h = 0; h < 2; ++h) v[h][i] = (unsigned)((h * 128 + R) * ULD + C) * 2u; }
    }
    __device__ __forceinline__ void mid(AccT&, const Unit&, int, int, int, int) const {}
    __device__ __forceinline__ void epi(const AccT& acc, const Unit& u, int wr, int wc, int fr, int fq) const {
        int row0 = u.pm * 256 + wr * 64 + fr, n00 = u.pn * 256 + wc * 32 + 8 * fq; asm volatile("" : "+v"(row0), "+v"(n00));
        const int h0 = n00 & 15;
        const f32x4 d0 = *(const f32x4*)(dsk + u.e * 16 + h0), d1 = *(const f32x4*)(dsk + u.e * 16 + h0 + 4);
#pragma unroll
        for (int ai = 0; ai < 2; ++ai)
#pragma unroll
            for (int m = 0; m < 4; ++m) { const int col = row0 + ai * 128 + m * 16;
#pragma unroll
                for (int bj = 0; bj < 2; ++bj) { const int n0 = n00 + bj * 128;
                    const u32x4 uu = *(const u32x4*)(UB + (unsigned)((col * NG + u.e) * UK + n0));
                    float y[8];
                    y[0] = acc[ai][bj][m][0][0] + d0[0] * bflo(uu.x); y[1] = acc[ai][bj][m][0][1] + d0[1] * bfhi(uu.x); y[2] = acc[ai][bj][m][0][2] + d0[2] * bflo(uu.y); y[3] = acc[ai][bj][m][0][3] + d0[3] * bfhi(uu.y);
                    y[4] = acc[ai][bj][m][1][0] + d1[0] * bflo(uu.z); y[5] = acc[ai][bj][m][1][1] + d1[1] * bfhi(uu.z); y[6] = acc[ai][bj][m][1][2] + d1[2] * bflo(uu.w); y[7] = acc[ai][bj][m][1][3] + d1[3] * bfhi(uu.w);
#pragma unroll
                    for (int j = 0; j < 8; ++j) { const float yy = y[j]; y[j] = yy * fast_sigmoid(1.5957691216f * (yy + 0.044715f * yy * yy * yy)); }
                    u32x4 w; w.x = pk2(y[0], y[1]); w.y = pk2(y[2], y[3]); w.z = pk2(y[4], y[5]); w.w = pk2(y[6], y[7]);
                    *(u32x4*)(Z + (unsigned)((col * CH + (n0 >> 4)) * SSMW + u.e * 16 + h0)) = w; }
                if (m == 3) asm volatile("" ::: "memory"); }
    }
};
struct GroupedBase {
    const LAS int* ecnt; const LAS int* mbpre; int NT, G, c, nt, ldb;
    LAS unsigned char* mt;
    __device__ __forceinline__ LAS unsigned char* slot(const Unit& u) const { const int q = (u.ord * 21846) >> 16; return mt + (u.ord - 3 * q) * 3072; }
    __device__ __forceinline__ bool next(int i, Unit& u) const {
        u.ord = i;
        const int TM = __builtin_amdgcn_readfirstlane(mbpre[NE]); int mbg;
        if (G == 256) {
            const int x = c & 7, j = c >> 3, a = 32 / NT; mbg = (i * 8 + x) * a + j / NT; u.pn = j % NT; if (mbg >= TM) return false;
        } else { const int L = i * G + c; if (L >= TM * NT) return false; mbg = L / NT; u.pn = L - mbg * NT; }
        u.pm = mbg;
        const int ln_ = lane_id_now(); const int mv_ = mbpre[ln_ & 31];
        const int e = __builtin_popcountll(__builtin_amdgcn_ballot_w64(ln_ >= 1 && ln_ < NE && mv_ <= mbg));
        const int mb = mbg - mbpre[e]; const int rem = ecnt[e] - mb * 256;
        u.e = __builtin_amdgcn_readfirstlane(e); u.cnt = __builtin_amdgcn_readfirstlane(rem < 256 ? rem : 256);
        u.pm = __builtin_amdgcn_readfirstlane(u.pm); u.pn = __builtin_amdgcn_readfirstlane(u.pn);
        return true;
    }
    __device__ __forceinline__ void mid(AccT&, const Unit&, int, int, int, int) const {}
};
struct ProbGateUp : GroupedBase {
    static constexpr bool PERM = true, FP8 = true, AFTER_DRAIN = false, META = true, GATHER = true, PERM16 = false, INT8 = false, FP6B = (GU_FP6 != 0), FP6A = (GU_FP6A != 0), ASCALE = false; static constexpr int MID = -1, KSTEPA = X6KT;
    const unsigned char* X; const unsigned char* Wt; const int* rowl; const float* rowr; const float* bgu; unsigned char* H;
    __device__ __forceinline__ const char* a_ptr(const Unit&) const { return (const char*)X; }
    __device__ __forceinline__ const char* b_ptr(const Unit& u) const { return GU_FP6 ? (const char*)Wt + (size_t)((u.e * 8 + u.pn) * 8) * 24576 : (const char*)Wt + ((size_t)u.e * 2048 + (size_t)u.pn * 256) * DM; }
    __device__ __forceinline__ void a_voff(const Unit& u, unsigned (&v)[2][2], int tid_) const {
        const int mb = __builtin_amdgcn_readfirstlane(u.pm - mbpre[u.e]); const int* rl = rowl + (size_t)u.e * ROWCAP + mb * 256;
        int tz = tid_; asm volatile("" : "+v"(tz));
        if (GU_FP6A) { const int L = tz & 63, w16 = (tz >> 6) * 16;
#pragma unroll
            for (int h = 0; h < 2; ++h) { const int R0 = w16 + (L >> 2), R1 = w16 + ((L & 31) >> 1); int r0 = h * 128 + R0, r1 = h * 128 + R1; r0 = r0 < u.cnt ? r0 : 0; r1 = r1 < u.cnt ? r1 : 0;
                const int t0 = rl[(unsigned)r0] >> 2, t1 = rl[(unsigned)r1] >> 2;
                v[h][0] = (unsigned)(t0 * X6ROW + (((L & 3) ^ ((0 - (R0 >> 2)) & 3)) * 16)); v[h][1] = (unsigned)(t1 * X6ROW + 64 + (((L & 1) ^ ((R1 >> 3) & 1)) * 16)); }
            return; }
#pragma unroll
        for (int i = 0; i < 2; ++i) { int R, C; pg8::stage_rc(tz * 16 + i * 8192, R, C);
#pragma unroll
            for (int h = 0; h < 2; ++h) { int r = h * 128 + R; r = r < u.cnt ? r : 0; const int tok = rl[(unsigned)r] >> 2; v[h][i] = (unsigned)(tok * DM + C * 2); } }
    }
    __device__ __forceinline__ void a_voff_lds(const Unit& u, unsigned (&v)[2][2], int tid_) const {
        const LAS int* rl = (const LAS int*)(slot(u) + 2048);
        int tz = tid_; asm volatile("" : "+v"(tz));
        if (GU_FP6A) { const int L = tz & 63, w16 = (tz >> 6) * 16;
#pragma unroll
            for (int h = 0; h < 2; ++h) { const int R0 = w16 + (L >> 2), R1 = w16 + ((L & 31) >> 1); int r0 = h * 128 + R0, r1 = h * 128 + R1; r0 = r0 < u.cnt ? r0 : 0; r1 = r1 < u.cnt ? r1 : 0;
                const int t0 = rl[r0] >> 2, t1 = rl[r1] >> 2;
                v[h][0] = (unsigned)(t0 * X6ROW + (((L & 3) ^ ((0 - (R0 >> 2)) & 3)) * 16)); v[h][1] = (unsigned)(t1 * X6ROW + 64 + (((L & 1) ^ ((R1 >> 3) & 1)) * 16)); }
            return; }
#pragma unroll
        for (int i = 0; i < 2; ++i) { int R, C; pg8::stage_rc(tz * 16 + i * 8192, R, C);
#pragma unroll
            for (int h = 0; h < 2; ++h) { int r = h * 128 + R; r = r < u.cnt ? r : 0; const int tok = rl[r] >> 2; v[h][i] = (unsigned)(tok * DM + C * 2); } }
    }
    __device__ __forceinline__ void epi6(const AccT& acc, const Unit& u, int wr, int wc, int fr, int fq) const {
        const LAS float* rr_ = (const LAS float*)slot(u); const LAS float* bg = rr_ + 256 + wc * 32 + 8 * fq;
        int r0 = wr * 64 + fr; asm volatile("" : "+v"(r0));
        const f32x4 bg0 = *(const LAS f32x4*)(bg), bg1 = *(const LAS f32x4*)(bg + 4), bu0 = *(const LAS f32x4*)(bg + 128) + 1.0f, bu1 = *(const LAS f32x4*)(bg + 132) + 1.0f;
        unsigned char* img = H + (size_t)(u.pm * 8 + u.pn) * 25600;
        const int rh = wr * 64 + fq * 16 + fr;
        const unsigned o16 = (unsigned)(rh * 64 + ((wc ^ ((0 - (rh >> 2)) & 3)) * 16)), o8 = (unsigned)(8192 + rh * 32 + ((wc ^ (2 * ((rh >> 3) & 1))) * 8)), osc = (unsigned)(24576 + rh * 4 + wc);
#pragma unroll
        for (int ai = 0; ai < 2; ++ai) { unsigned P[4][4];
#pragma unroll
            for (int m = 0; m < 4; ++m) { const int r = r0 + ai * 128 + m * 16; const float rs = rr_[r < u.cnt ? r : 0] * W8_INV; float o[8];
#pragma unroll
                for (int n = 0; n < 2; ++n) { const f32x4 gb = n ? bg1 : bg0, ub = n ? bu1 : bu0; const f32x4 ag = acc[ai][0][m][n], au = acc[ai][1][m][n];
#pragma unroll
                    for (int jp = 0; jp < 2; ++jp) {
                        const f32x2 rs2 = {rs, rs};
                        f32x2 g2 = (f32x2){ag[2 * jp], ag[2 * jp + 1]} * rs2 + (f32x2){gb[2 * jp], gb[2 * jp + 1]};
                        f32x2 u2 = (f32x2){au[2 * jp], au[2 * jp + 1]} * rs2 + (f32x2){ub[2 * jp], ub[2 * jp + 1]};
                        g2[0] = fminf(g2[0], 7.0f); g2[1] = fminf(g2[1], 7.0f); u2[0] = __builtin_amdgcn_fmed3f(u2[0], -6.0f, 8.0f); u2[1] = __builtin_amdgcn_fmed3f(u2[1], -6.0f, 8.0f);
                        const f32x2 t2 = g2 * (f32x2){-1.702f * 1.44269504f, -1.702f * 1.44269504f};
                        const f32x2 d2 = (f32x2){__builtin_amdgcn_exp2f(t2[0]), __builtin_amdgcn_exp2f(t2[1])} + (f32x2){1.0f, 1.0f};
                        const f32x2 o2 = g2 * (f32x2){__builtin_amdgcn_rcpf(d2[0]), __builtin_amdgcn_rcpf(d2[1])} * u2;
                        o[n * 4 + 2 * jp] = o2[0]; o[n * 4 + 2 * jp + 1] = o2[1]; } }
                P[m][0] = pk2(o[0], o[1]); P[m][1] = pk2(o[2], o[3]); P[m][2] = pk2(o[4], o[5]); P[m][3] = pk2(o[6], o[7]); }
#pragma unroll
            for (int k = 0; k < 4; ++k) { const auto a = __builtin_amdgcn_permlane16_swap(P[0][k], P[1][k], false, false); P[0][k] = a[0]; P[1][k] = a[1];
                                          const auto b = __builtin_amdgcn_permlane16_swap(P[2][k], P[3][k], false, false); P[2][k] = b[0]; P[3][k] = b[1]; }
#pragma unroll
            for (int k = 0; k < 4; ++k) { const auto a = __builtin_amdgcn_permlane32_swap(P[0][k], P[2][k], false, false); P[0][k] = a[0]; P[2][k] = a[1];
                                          const auto b = __builtin_amdgcn_permlane32_swap(P[1][k], P[3][k], false, false); P[1][k] = b[0]; P[3][k] = b[1]; }
            typedef unsigned short us2 __attribute__((ext_vector_type(2))); us2 mx = {0, 0};
#pragma unroll
            for (int m = 0; m < 4; ++m)
#pragma unroll
                for (int k = 0; k < 4; ++k) mx = __builtin_elementwise_max(mx, __builtin_bit_cast(us2, P[m][k] & 0x7fff7fffu));
            const float am = __uint_as_float((unsigned)(mx[0] > mx[1] ? mx[0] : mx[1]) << 16);
            const unsigned vb = __float_as_uint(am * (1.0f / 7.5f)); unsigned e2 = ((vb >> 23) & 255u) + ((vb & 0x7fffffu) ? 1u : 0u);
            const bool ok = am > 0.f && e2 >= 1u && e2 <= 253u; e2 = ok ? e2 : 127u; const float s2 = __uint_as_float(e2 << 23);
            typedef unsigned u32x16 __attribute__((ext_vector_type(16))); typedef __bf16 b32v __attribute__((ext_vector_type(32)));
            const u32x16 wv = {P[0][0], P[0][1], P[0][2], P[0][3], P[1][0], P[1][1], P[1][2], P[1][3], P[2][0], P[2][1], P[2][2], P[2][3], P[3][0], P[3][1], P[3][2], P[3][3]};
            const u32x6 pk = __builtin_amdgcn_cvt_scalef32_pk32_fp6_bf16(__builtin_bit_cast(b32v, wv), s2);
            unsigned char* d = img + ai * 12288;
            *(u32x4*)(d + o16) = (u32x4){pk[0], pk[1], pk[2], pk[3]}; *(u32x2*)(d + o8) = (u32x2){pk[4], pk[5]}; img[osc + ai * 512] = (unsigned char)e2;
            asm volatile("" ::: "memory"); }
    }
    __device__ __forceinline__ void meta(const Unit& u, int lane) const {
        const int mb = __builtin_amdgcn_readfirstlane(u.pm - mbpre[u.e]); LAS unsigned char* t = slot(u); const size_t ro = (size_t)u.e * ROWCAP + mb * 256 + lane * 4;
        __builtin_amdgcn_global_load_lds((const unsigned*)(rowr + ro), (LAS unsigned*)t, 16, 0, 0);
        const float* bsrc = bgu + (size_t)u.e * 2048 + u.pn * 128 + (lane < 32 ? lane * 4 : 1024 + (lane - 32) * 4);
        __builtin_amdgcn_global_load_lds((const unsigned*)bsrc, (LAS unsigned*)(t + 1024), 16, 0, 0);
        __builtin_amdgcn_global_load_lds((const unsigned*)(rowl + ro), (LAS unsigned*)(t + 2048), 16, 0, 0);
    }
    __device__ __forceinline__ void epi(const AccT& acc, const Unit& u, int wr, int wc, int fr, int fq) const {
        if (DN_FP6A) { epi6(acc, u, wr, wc, fr, fq); return; }
        const LAS float* rr_ = (const LAS float*)slot(u); const LAS float* bg = rr_ + 256 + wc * 32 + 8 * fq;
        int r0 = wr * 64 + fr, col0 = u.pn * 128 + wc * 32 + 8 * fq; asm volatile("" : "+v"(r0), "+v"(col0));
        const f32x4 bg0 = *(const LAS f32x4*)(bg), bg1 = *(const LAS f32x4*)(bg + 4), bu0 = *(const LAS f32x4*)(bg + 128) + 1.0f, bu1 = *(const LAS f32x4*)(bg + 132) + 1.0f;
#pragma unroll
        for (int ai = 0; ai < 2; ++ai)
#pragma unroll
            for (int mp = 0; mp < 2; ++mp) { u32x2 w[2]; float rsv[2];
#pragma unroll
                for (int mm = 0; mm < 2; ++mm) { const int r = r0 + ai * 128 + (2 * mp + mm) * 16; rsv[mm] = rr_[r < u.cnt ? r : 0]; }
#pragma unroll
                for (int mm = 0; mm < 2; ++mm) { const int m = 2 * mp + mm; const float rs = rsv[mm] * W8_INV;
                    float o[8];
#pragma unroll
                    for (int n = 0; n < 2; ++n) { const f32x4 gb = n ? bg1 : bg0, ub = n ? bu1 : bu0;
#pragma unroll
                        for (int j = 0; j < 4; ++j) { float gt = acc[ai][0][m][n][j] * rs + gb[j], up = acc[ai][1][m][n][j] * rs + ub[j];
                            gt = fminf(gt, 7.0f); up = __builtin_amdgcn_fmed3f(up, -6.0f, 8.0f);
                            o[n * 4 + j] = gt * __builtin_amdgcn_rcpf(1.0f + __builtin_amdgcn_exp2f(gt * (-1.702f * 1.44269504f))) * up; } }
                    w[mm].x = pk4_fp8(o[0], o[1], o[2], o[3]); w[mm].y = pk4_fp8(o[4], o[5], o[6], o[7]); asm volatile("" : "+v"(w[mm].x), "+v"(w[mm].y)); }
                const auto sx = __builtin_amdgcn_permlane16_swap(w[0].x, w[1].x, false, false), sy = __builtin_amdgcn_permlane16_swap(w[0].y, w[1].y, false, false);
                u32x4 q; q.x = sx[0]; q.y = sy[0]; q.z = sx[1]; q.w = sy[1];
                const int r = r0 + ai * 128 + mp * 32 + (fq & 1) * 16;
                *(u32x4*)(H + (unsigned)((u.pm * 256 + r) * DM + col0 - 8 * (fq & 1))) = q;
                asm volatile("" ::: "memory"); }
    }
};
struct ProbDown : GroupedBase {
    static constexpr bool PERM = true, FP8 = true, AFTER_DRAIN = false, META = true, GATHER = false, PERM16 = (DN_FP6 == 0), INT8 = false, FP6B = (DN_FP6 != 0), FP6A = (DN_FP6A != 0), ASCALE = (DN_FP6A != 0); static constexpr int MID = -1, KSTEPA = 25600;
    const unsigned char* Hm; const unsigned char* Wt; const int* rowl; const float* gate; const float* bdn; unsigned char* Y;
    __device__ __forceinline__ const char* a_ptr(const Unit& u) const { return DN_FP6A ? (const char*)Hm + (size_t)(u.pm * 8) * 25600 : (const char*)Hm + (size_t)u.pm * 256 * DM; }
    __device__ __forceinline__ const char* b_ptr(const Unit& u) const { return DN_FP6 ? (const char*)Wt + (size_t)((u.e * 4 + u.pn) * 8) * 24576 : (const char*)Wt + ((size_t)u.e * 1024 + (size_t)u.pn * 256) * DM; }
    __device__ __forceinline__ void a_voff(const Unit&, unsigned (&v)[2][2], int tid_) const {
        int tz = tid_; asm volatile("" : "+v"(tz));
        if (DN_FP6A) { const int L = tz & 63, w = tz >> 6;
#pragma unroll
            for (int h = 0; h < 2; ++h) { v[h][0] = 0u; v[h][1] = 0u; }
            return; }
#pragma unroll
        for (int i = 0; i < 2; ++i) { int R, C; pg8::stage_rc(tz * 16 + i * 8192, R, C);
#pragma unroll
            for (int h = 0; h < 2; ++h) v[h][i] = (unsigned)((h * 128 + R) * DM + C * 2); }
    }
    __device__ __forceinline__ void a_voff_lds(const Unit& u, unsigned (&v)[2][2], int tid_) const { a_voff(u, v, tid_); }
    __device__ __forceinline__ void meta(const Unit& u, int lane) const {
        const int mb = __builtin_amdgcn_readfirstlane(u.pm - mbpre[u.e]); LAS unsigned char* t = slot(u); const size_t ro = (size_t)u.e * ROWCAP + mb * 256 + lane * 4;
        __builtin_amdgcn_global_load_lds((const unsigned*)(gate + ro), (LAS unsigned*)t, 16, 0, 0);
        __builtin_amdgcn_global_load_lds((const unsigned*)(bdn + (size_t)u.e * DM + u.pn * 256 + lane * 4), (LAS unsigned*)(t + 1024), 16, 0, 0);
        __builtin_amdgcn_global_load_lds((const unsigned*)(rowl + ro), (LAS unsigned*)(t + 2048), 16, 0, 0);
    }
    __device__ __forceinline__ void epi(const AccT& acc, const Unit& u, int wr, int wc, int fr, int fq) const {
        if (DN_FP6) {
            const LAS float* rg = (const LAS float*)slot(u); const LAS int* rl = (const LAS int*)(rg + 512);
            int r0 = wr * 64 + fr, cb = wc * 32 + 8 * fq; asm volatile("" : "+v"(r0), "+v"(cb));
            f32x4 bv[2][2];
#pragma unroll
            for (int bj = 0; bj < 2; ++bj)
#pragma unroll
                for (int n = 0; n < 2; ++n) bv[bj][n] = *(const LAS f32x4*)(rg + 256 + bj * 128 + cb + 4 * n);
            const int odd = fq & 1;
#pragma unroll
            for (int ai = 0; ai < 2; ++ai)
#pragma unroll
                for (int mp = 0; mp < 2; ++mp) { const int ra = r0 + ai * 128 + mp * 32, rb = ra + 16; const float ga = rg[ra] * Y8_SCALE, gb = rg[rb] * Y8_SCALE;
                    const int rs_ = odd ? rb : ra; const bool ok = rs_ < u.cnt; const int tokk = rl[ok ? rs_ : 0];
#pragma unroll
                    for (int bj = 0; bj < 2; ++bj) { u32x2 wa, wb;
                        { const f32x4 v0 = (acc[ai][bj][2 * mp][0] * W8_INV + bv[bj][0]) * ga, v1 = (acc[ai][bj][2 * mp][1] * W8_INV + bv[bj][1]) * ga; wa.x = pk4_fp8(v0[0], v0[1], v0[2], v0[3]); wa.y = pk4_fp8(v1[0], v1[1], v1[2], v1[3]); }
                        { const f32x4 v0 = (acc[ai][bj][2 * mp + 1][0] * W8_INV + bv[bj][0]) * gb, v1 = (acc[ai][bj][2 * mp + 1][1] * W8_INV + bv[bj][1]) * gb; wb.x = pk4_fp8(v0[0], v0[1], v0[2], v0[3]); wb.y = pk4_fp8(v1[0], v1[1], v1[2], v1[3]); }
                        const auto sx = __builtin_amdgcn_permlane16_swap(wa.x, wb.x, false, false), sy = __builtin_amdgcn_permlane16_swap(wa.y, wb.y, false, false);
                        u32x4 q; q.x = sx[0]; q.y = sy[0]; q.z = sx[1]; q.w = sy[1];
                        if (ok) *(u32x4*)(Y + (unsigned)(tokk * DM + u.pn * 256 + bj * 128 + cb - 8 * odd)) = q; } }
            return; }
        const LAS float* rg = (const LAS float*)slot(u); const LAS float* bb = rg + 256 + wc * 64 + 16 * fq; const LAS int* rl = (const LAS int*)(rg + 512);
        int r0 = wr * 64 + fr, col0 = u.pn * 256 + wc * 64 + 16 * fq; asm volatile("" : "+v"(r0), "+v"(col0));
        f32x4 bv[2][2];
#pragma unroll
        for (int bj = 0; bj < 2; ++bj)
#pragma unroll
            for (int n = 0; n < 2; ++n) bv[bj][n] = *(const LAS f32x4*)(bb + 8 * bj + 4 * n);
#pragma unroll
        for (int ai = 0; ai < 2; ++ai)
#pragma unroll
            for (int m = 0; m < 4; ++m) { const int r = r0 + ai * 128 + m * 16;
                if (r < u.cnt) { const int tokk = rl[r]; const float gt = rg[r] * Y8_SCALE;
                    u32x4 w;
#pragma unroll
                    for (int bj = 0; bj < 2; ++bj)
#pragma unroll
                        for (int n = 0; n < 2; ++n) { const f32x4 v = (acc[ai][bj][m][n] * W8_INV + bv[bj][n]) * gt; w[2 * bj + n] = pk4_fp8(v[0], v[1], v[2], v[3]); }
                    *(u32x4*)(Y + (unsigned)(tokk * DM + col0)) = w; } }
    }
};

struct TDesc { const float* src; const float* gk; unsigned char* dst; int ldn, pitch, fp8, valid; };
__device__ __forceinline__ TDesc tdesc_make(const float* W, int ldn, int k0, int n0, const float* gk, void* WT, int ldk, int drow0, int fp8) {
    TDesc d; d.src = W + (size_t)k0 * ldn + n0; d.gk = gk ? gk + k0 : nullptr; d.ldn = ldn; d.fp8 = fp8; d.valid = 1;
    d.pitch = fp8 ? ldk : ldk * 2; d.dst = (unsigned char*)WT + (size_t)drow0 * d.pitch + (fp8 ? k0 : k0 * 2); return d;
}
__device__ __forceinline__ TDesc tdesc_decode(const Frame& F, int it) {
    constexpr int I_IN = 16 * 48, I_GLU = 8 * 16, I_OUT = 16 * 32, I_GU = NE * 16 * 64, I_DN = NE * 16 * 32, I_L = I_IN + I_GLU + I_OUT + I_GU + I_DN;
    if (GU_FP6 && DN_FP6) {
        const int l = it / (I_GLU + I_OUT), r = it - l * (I_GLU + I_OUT); unsigned char* wl = F.ws + WS_W + (size_t)l * WL_STRIDE;
        if (r < I_GLU) { const int kb = r / 16, nb = r % 16; return tdesc_make(F.in[11] + (size_t)l * SSMW * SSMW, SSMW, kb * 64, nb * 32, nullptr, wl + WL_GLU, SSMW, nb * 32, 0); }
        const int r2 = r - I_GLU, kb = r2 / 32, nb = r2 % 32; return tdesc_make(F.in[17] + (size_t)l * DM * DM, DM, kb * 64, nb * 32, F.in[16] + l * DM, wl + WL_OUT, DM, nb * 32, 0); }
    const int l = it / I_L; int r = it - l * I_L;
    unsigned char* wl = F.ws + WS_W + (size_t)l * WL_STRIDE;
    if (r < I_IN) { const int kb = r / 48, nb = r % 48;
        TDesc d = tdesc_make(F.in[2] + (size_t)l * DM * INW, INW, kb * 64, nb * 32, F.in[1] + l * DM, wl + WL_IN, DM, nb * 32, 0);
        d.valid = 0;
        return d; } r -= I_IN;
    if (r < I_GLU) { const int kb = r / 16, nb = r % 16; return tdesc_make(F.in[11] + (size_t)l * SSMW * SSMW, SSMW, kb * 64, nb * 32, nullptr, wl + WL_GLU, SSMW, nb * 32, 0); } r -= I_GLU;
    if (r < I_OUT) { const int kb = r / 32, nb = r % 32; return tdesc_make(F.in[17] + (size_t)l * DM * DM, DM, kb * 64, nb * 32, F.in[16] + l * DM, wl + WL_OUT, DM, nb * 32, 0); } r -= I_OUT;
    if (r < I_GU) { const int e = r / 1024, q = r % 1024, kb = q / 64, nb = q % 64, n0 = nb * 32;
        const int drow0 = ((n0 & 1023) >> 7) * 256 + (n0 >> 10) * 128 + (n0 & 127);
        TDesc d = tdesc_make(F.in[21] + ((size_t)l * NE + e) * DM * 2048, 2048, kb * 64, n0, F.in[18] + l * DM, wl + WL_GU + (size_t)e * 2048 * DM, DM, drow0, 1);
        if (GU_FP6) d.valid = 0;
        return d; } r -= I_GU;
    { const int e = r / 512, q = r % 512, kb = q / 32, nb = q % 32;
        TDesc d = tdesc_make(F.in[23] + ((size_t)l * NE + e) * DM * DM, DM, kb * 64, nb * 32, nullptr, wl + WL_DN + (size_t)e * DM * DM, DM, nb * 32, 1); if (DN_FP6) d.valid = 0; return d; }
}
__device__ __forceinline__ void tdesc_load(const TDesc& d, f32x4 (&v)[8], int lane) {
    const int rr = lane >> 3, c4 = (lane & 7) * 4;
    if (d.valid) {
#pragma unroll
        for (int i = 0; i < 8; ++i) v[i] = *(const f32x4*)(d.src + (size_t)(i * 8 + rr) * d.ldn + c4); }
}
__device__ __forceinline__ void tdesc_finish(const TDesc& d, const f32x4 (&v)[8], LAS float* scr, int lane) {
    if (!d.valid) return;
    { const int rr = lane >> 3, c4 = (lane & 7) * 4; const float sc = d.fp8 ? W8_SCALE : 1.0f;
#pragma unroll
      for (int i = 0; i < 8; ++i) { const int kk = i * 8 + rr; const float g = d.gk ? d.gk[kk] * sc : sc;
#pragma unroll
          for (int j = 0; j < 4; ++j) scr[kk * 33 + c4 + j] = v[i][j] * g; } }
    LDS_WAIT();
    const int c = lane & 7;
#pragma unroll
    for (int j = 0; j < 4; ++j) { const int n = (lane >> 3) + 8 * j; const LAS float* s = scr + (8 * c) * 33 + n;
        if (d.fp8) { u32x2 o; o.x = pk4_fp8(s[0 * 33], s[1 * 33], s[2 * 33], s[3 * 33]); o.y = pk4_fp8(s[4 * 33], s[5 * 33], s[6 * 33], s[7 * 33]); *(u32x2*)(d.dst + (size_t)n * d.pitch + 8 * c) = o; }
        else { u32x4 o; o.x = pk2(s[0 * 33], s[1 * 33]); o.y = pk2(s[2 * 33], s[3 * 33]); o.z = pk2(s[4 * 33], s[5 * 33]); o.w = pk2(s[6 * 33], s[7 * 33]); *(u32x4*)(d.dst + (size_t)n * d.pitch + 16 * c) = o; } }
    LDS_WAIT();
}
struct T6Desc { const float* src; const float* gk; unsigned char* d16; unsigned char* d8; int ldn; };
__device__ __forceinline__ T6Desc t6_decode(const Frame& F, int it) {
    if (it >= DEPTH * 16384) {
        const int i2 = it - DEPTH * 16384, l = i2 >> 13, r = i2 & 8191, g = r & 3, pn = (r >> 2) & 3, h = (r >> 4) & 1, t = (r >> 5) & 7, e = r >> 8;
        T6Desc d; d.src = F.in[23] + ((size_t)l * NE + e) * DM * DM + (size_t)(t * 128) * DM + pn * 256 + h * 128 + g * 32; d.gk = nullptr; d.ldn = DM;
        unsigned char* img = F.ws + WS_W + (size_t)l * WL_STRIDE + WL_DN + (size_t)((e * 4 + pn) * 8 + t) * 24576 + h * 12288;
        d.d16 = img + g * 2048; d.d8 = img + 8192 + g * 1024; return d; }
    const int l = it >> 14, r = it & 16383, g = r & 3, pn = (r >> 2) & 7, h = (r >> 5) & 1, t = (r >> 6) & 7, e = r >> 9;
    T6Desc d; d.ldn = 2048; d.src = F.in[21] + ((size_t)l * NE + e) * DM * 2048 + (size_t)(t * 128) * 2048 + h * 1024 + pn * 128 + g * 32; d.gk = F.in[18] + l * DM + t * 128;
    unsigned char* img = F.ws + WS_W + (size_t)l * WL_STRIDE + WL_GU + (size_t)((e * 8 + pn) * 8 + t) * 24576 + h * 12288;
    d.d16 = img + g * 2048; d.d8 = img + 8192 + g * 1024; return d;
}
__device__ __forceinline__ void t6_load(const T6Desc& d, f32x4 (&v)[16], int lane) {
    const unsigned o = (unsigned)(((lane >> 3) * d.ldn + (lane & 7) * 4) * 4);
#pragma unroll
    for (int i = 0; i < 16; ++i) { const char* bi = (const char*)d.src + (size_t)i * (size_t)(8 * 4) * d.ldn; asm volatile("" : "+s"(bi)); v[i] = *(const f32x4*)(bi + o); }
}
__device__ __forceinline__ void t6_finish(const T6Desc& d, const f32x4 (&v)[16], LAS float* scr, int lane) {
    { const int rr = lane >> 3, c4 = (lane & 7) * 4;
#pragma unroll
      for (int i = 0; i < 16; ++i) { const int kk = i * 8 + rr; const float g = d.gk ? d.gk[kk] * W8_SCALE : W8_SCALE;
#pragma unroll
          for (int j = 0; j < 4; ++j) scr[kk * 33 + c4 + j] = v[i][j] * g; } }
    LDS_WAIT();
    const int rho = lane & 31, col = pg8::perm32(rho), fqb = lane >> 5;
    u32x6 pk[2];
#pragma unroll
    for (int p = 0; p < 2; ++p) { const int fq = 2 * p + fqb; h32 hv;
#pragma unroll
        for (int i = 0; i < 32; ++i) hv[i] = (_Float16)scr[(fq * 32 + i) * 33 + col];
        pk[p] = __builtin_amdgcn_cvt_scalef32_pk32_fp6_f16(hv, 1.0f); }
    LDS_WAIT();
    LAS unsigned char* sb = (LAS unsigned char*)scr;
#pragma unroll
    for (int p = 0; p < 2; ++p) { const int fq = 2 * p + fqb, s16 = fq ^ ((0 - (rho >> 2)) & 3), s8 = fq ^ (2 * ((rho >> 3) & 1));
        *(LAS u32x4*)(sb + rho * 64 + s16 * 16) = (u32x4){pk[p][0], pk[p][1], pk[p][2], pk[p][3]};
        *(LAS u32x2*)(sb + 2048 + rho * 32 + s8 * 8) = (u32x2){pk[p][4], pk[p][5]}; }
    LDS_WAIT();
    { const u32x4 a = *(const LAS u32x4*)(sb + lane * 16), b = *(const LAS u32x4*)(sb + 1024 + lane * 16), c = *(const LAS u32x4*)(sb + 2048 + lane * 16);
      const unsigned o = (unsigned)(lane * 16); *(u32x4*)(d.d16 + o) = a; *(u32x4*)(d.d16 + (o + 1024u)) = b; *(u32x4*)(d.d8 + o) = c; }
    LDS_WAIT();
}
__device__ __forceinline__ void prologue_phase(const Frame& F) {
    LAS float* scr = (LAS float*)(F.lds + F.wave * 16896);
    constexpr int I_TOT = (GU_FP6 && DN_FP6) ? DEPTH * (8 * 16 + 16 * 32) : DEPTH * (16 * 48 + 8 * 16 + 16 * 32 + NE * 16 * 64 + NE * 16 * 32);
    if (F.gw < I_TOT) {
        int it = F.gw; TDesc cur = tdesc_decode(F, it); f32x4 vc[8]; tdesc_load(cur, vc, F.lane);
        for (;;) { const int itn = it + F.ngw; const bool hn = itn < I_TOT; TDesc nx = cur; f32x4 vn[8];
#pragma unroll
            for (int i = 0; i < 8; ++i) vn[i] = vc[i];
            if (hn) { nx = tdesc_decode(F, itn); tdesc_load(nx, vn, F.lane); }
            tdesc_finish(cur, vc, scr, F.lane);
            if (!hn) break;
            cur = nx; it = itn;
#pragma unroll
            for (int i = 0; i < 8; ++i) vc[i] = vn[i]; }
    }
    if (GU_FP6) {
        LAS float* scr6 = (LAS float*)(F.lds + F.wave * 16896);
        constexpr int I6 = DEPTH * 16384 + (DN_FP6 ? DEPTH * 8192 : 0);
        if (F.gw < I6) { int it = F.gw; T6Desc dA = t6_decode(F, it), dB = dA; f32x4 vA[16], vB[16];
            t6_load(dA, vA, F.lane);
            for (;;) {
                const bool hb = it + F.ngw < I6; if (hb) { dB = t6_decode(F, it + F.ngw); t6_load(dB, vB, F.lane); }
                t6_finish(dA, vA, scr6, F.lane); if (!hb) break; it += F.ngw;
                const bool ha = it + F.ngw < I6; if (ha) { dA = t6_decode(F, it + F.ngw); t6_load(dA, vA, F.lane); }
                t6_finish(dB, vB, scr6, F.lane); if (!ha) break; it += F.ngw; } } }
    { const float* x = F.in[0]; bf16* xb = wsp<bf16>(F, WS_XBF); unsigned char* xq = wsp<unsigned char>(F, WS_XQ); float* rs = wsp<float>(F, WS_RSTD0);
      for (int tok0 = 2 * F.gw; tok0 < NTOK; tok0 += 2 * F.ngw) { f32x4 v[2][4];
#pragma unroll
          for (int r = 0; r < 2; ++r)
#pragma unroll
              for (int j = 0; j < 4; ++j) v[r][j] = *(const f32x4*)(x + (size_t)(tok0 + r) * DM + 4 * F.lane + 256 * j);
#pragma unroll
          for (int r = 0; r < 2; ++r) { const size_t tok = tok0 + r; float ss = 0.f, am = 0.f;
#pragma unroll
              for (int j = 0; j < 4; ++j) { ss += (v[r][j][0] * v[r][j][0] + v[r][j][1] * v[r][j][1]) + (v[r][j][2] * v[r][j][2] + v[r][j][3] * v[r][j][3]);
                  am = fmaxf(am, fmaxf(fmaxf(fabsf(v[r][j][0]), fabsf(v[r][j][1])), fmaxf(fabsf(v[r][j][2]), fabsf(v[r][j][3])))); }
              ss = wave_sum_dpp(ss); am = wave_max_dpp(am);
              const float sc = am > 0.f ? am * (1.0f / 127.0f) : 1.0f, qs = 1.0f / sc;
#pragma unroll
              for (int j = 0; j < 4; ++j) { u32x2 w; w.x = pk2(v[r][j][0], v[r][j][1]); w.y = pk2(v[r][j][2], v[r][j][3]); *(u32x2*)(xb + tok * DM + 4 * F.lane + 256 * j) = w;
                  *(unsigned*)(xq + tok * DM + 4 * F.lane + 256 * j) = pk4_i8(v[r][j][0] * qs, v[r][j][1] * qs, v[r][j][2] * qs, v[r][j][3] * qs); }
              if (F.lane == 0) rs[tok] = __builtin_amdgcn_rsqf(ss * (1.0f / DM) + EPS) * sc; } } }
    { float* fold = wsp<float>(F, WS_FOLD);
      for (int q = blockIdx.x * NTHREADS + F.tid; q < DEPTH * DM * 64; q += F.G * NTHREADS) { const int l = q / (DM * 64), k = (q >> 6) & (DM - 1), id4 = (q & 63) * 4, i = id4 >> 6, d = id4 & 63;
          const float* wrow = F.in[2] + ((size_t)l * DM + k) * INW + 512 + 64 * i; const float* pw = F.in[13] + ((size_t)(l * 4 + i) * 64) * 64 + d; f32x4 acc = {0.f, 0.f, 0.f, 0.f};
#pragma unroll 4
          for (int c4 = 0; c4 < 16; ++c4) { const f32x4 wv = *(const f32x4*)(wrow + 4 * c4);
#pragma unroll
              for (int j = 0; j < 4; ++j) acc += wv[j] * *(const f32x4*)(pw + (4 * c4 + j) * 64); }
          const float g = F.in[1][l * DM + k];
#pragma unroll
          for (int j = 0; j < 4; ++j) fold[((size_t)l * 256 + id4 + j) * DM + k] = acc[j] * g; } }
    { unsigned* cmax = wsp<unsigned>(F, WS_CTL) + CW_CMAX;
      for (int it = F.gw; it < DEPTH * 16 * 48; it += F.ngw) { const int l = it / 768, r = it % 768, kb = r / 48, nb = r % 48; if (nb >= 16 && nb < 24) continue;
          const int rr = F.lane >> 3, c4 = (F.lane & 7) * 4; const float* src = F.in[2] + ((size_t)l * DM + kb * 64) * INW + nb * 32 + c4; const float* g = F.in[1] + l * DM + kb * 64;
          f32x4 m = {0.f, 0.f, 0.f, 0.f};
#pragma unroll
          for (int i = 0; i < 8; ++i) { const f32x4 v = *(const f32x4*)(src + (size_t)(i * 8 + rr) * INW); const float gg = fabsf(g[i * 8 + rr]);
#pragma unroll
              for (int j = 0; j < 4; ++j) m[j] = fmaxf(m[j], fabsf(v[j]) * gg); }
#pragma unroll
          for (int j = 0; j < 4; ++j) { float t = m[j]; t = fmaxf(t, shx(t, 8, F.lane)); t = fmaxf(t, shx(t, 16, F.lane)); t = fmaxf(t, shx(t, 32, F.lane));
              if (F.lane < 8) atomicMax(cmax + l * INW + nb * 32 + c4 + j, __float_as_uint(t)); } } }
    { float* wr = wsp<float>(F, WS_WR);
      for (int i = blockIdx.x * NTHREADS + F.tid; i < DEPTH * NE * DM; i += F.G * NTHREADS) { const int l = i / (NE * DM), e = (i / DM) % NE, k = i % DM;
          wr[i] = F.in[18][l * DM + k] * F.in[19][((size_t)l * DM + k) * NE + e]; } }
    { f32x4* sa = wsp<f32x4>(F, WS_SSMA); float* sb = wsp<float>(F, WS_SSMB); f32x2* apw = wsp<f32x2>(F, WS_APOW);
      for (int q = blockIdx.x * NTHREADS + F.tid; q < DEPTH * NG * SP * 33; q += F.G * NTHREADS) { const int i = q / 33, j = q - i * 33, lg = i / SP;
          const float lr = fminf(F.in[3][i], -1e-4f), li = F.in[4][i], step = __expf(F.in[10][lg]);
          const float mj = __expf((float)j * lr * step), aj = (float)j * (li * step), pr = mj * cosf(aj), pi = mj * sinf(aj);
          apw[q] = (f32x2){pr, pi};
          if (j == 1) { const float ar = pr, ai = pi; const float m32 = __expf(32.0f * lr * step), a32 = 32.0f * (li * step);
              sa[i] = (f32x4){ar, ai, m32 * cosf(a32), m32 * sinf(a32)};
              const float nr = ar - 1.0f, den = lr * lr + li * li, kr = (nr * lr + ai * li) / den, ki = (ai * lr - nr * li) / den;
#pragma unroll
              for (int h = 0; h < 16; ++h) { const float br = F.in[5][(size_t)i * 16 + h], bi = F.in[6][(size_t)i * 16 + h];
                  sb[(size_t)i * 32 + h] = kr * br - ki * bi; sb[(size_t)i * 32 + 16 + h] = kr * bi + ki * br; } } } }
}

__device__ __forceinline__ void winq_phase(const Frame& F) {
    const unsigned* cmax = wsp<unsigned>(F, WS_CTL) + CW_CMAX; float* sw = wsp<float>(F, WS_SWIN); const float* fold = wsp<float>(F, WS_FOLD);
    LAS float* scr = (LAS float*)(F.lds + 32768 + F.wave * 8704);
    for (int it = F.gw; it < DEPTH * 16 * 48; it += F.ngw) { const int l = it / 768, r = it % 768, kb = r / 48, nb = r % 48; if (nb >= 16 && nb < 24) continue;
        unsigned char* wq = F.ws + WS_W + (size_t)l * WL_STRIDE + WL_IN;
        const int rr = F.lane >> 3, c4 = (F.lane & 7) * 4; const float* src = F.in[2] + ((size_t)l * DM + kb * 64) * INW + nb * 32 + c4; const float* g = F.in[1] + l * DM + kb * 64;
#pragma unroll
        for (int i = 0; i < 8; ++i) { const f32x4 v = *(const f32x4*)(src + (size_t)(i * 8 + rr) * INW); const float gg = g[i * 8 + rr];
#pragma unroll
            for (int j = 0; j < 4; ++j) scr[(i * 8 + rr) * 33 + c4 + j] = v[j] * gg; }
        LDS_WAIT();
        const int c = F.lane & 7;
#pragma unroll
        for (int j = 0; j < 4; ++j) { const int n = (F.lane >> 3) + 8 * j; const LAS float* t = scr + (8 * c) * 33 + n;
            const float cm = __uint_as_float(__hip_atomic_load(cmax + l * INW + nb * 32 + n, __ATOMIC_RELAXED, __HIP_MEMORY_SCOPE_AGENT)); const float qs = cm > 0.f ? 127.0f / cm : 0.f;
            u32x2 o; o.x = pk4_i8(t[0 * 33] * qs, t[1 * 33] * qs, t[2 * 33] * qs, t[3 * 33] * qs); o.y = pk4_i8(t[4 * 33] * qs, t[5 * 33] * qs, t[6 * 33] * qs, t[7 * 33] * qs);
            *(u32x2*)(wq + (size_t)(nb * 32 + n) * DM + kb * 64 + 8 * c) = o;
            if (kb == 0 && c == 0) sw[l * INW + nb * 32 + n] = cm * (1.0f / 127.0f); }
        LDS_WAIT();
    }
    for (int cid = F.gw; cid < DEPTH * 256; cid += F.ngw) { const int l = cid >> 8, id = cid & 255;
        const float* fp = fold + ((size_t)l * 256 + id) * DM + 16 * F.lane; f32x4 v[4]; float am = 0.f;
#pragma unroll
        for (int j = 0; j < 4; ++j) { v[j] = *(const f32x4*)(fp + 4 * j); am = fmaxf(am, fmaxf(fmaxf(fabsf(v[j][0]), fabsf(v[j][1])), fmaxf(fabsf(v[j][2]), fabsf(v[j][3])))); }
        am = wave_max(am); const float qs = am > 0.f ? 127.0f / am : 0.f;
        u32x4 o;
#pragma unroll
        for (int j = 0; j < 4; ++j) o[j] = pk4_i8(v[j][0] * qs, v[j][1] * qs, v[j][2] * qs, v[j][3] * qs);
        *(u32x4*)(F.ws + WS_W + (size_t)l * WL_STRIDE + WL_IN + (size_t)(512 + id) * DM + 16 * F.lane) = o;
        if (F.lane == 0) sw[l * INW + 512 + id] = am * (1.0f / 127.0f); }
}
__device__ __forceinline__ void ktab_phase(const Frame& F) {
    LAS float* Cr = (LAS float*)F.lds; LAS float* Ci = Cr + 1024; LAS float* Br = Ci + 1024; LAS float* Bi = Br + 1024; LAS f32x2* Ap = (LAS f32x2*)(Bi + 1024);
    const float* sb = wsp<float>(F, WS_SSMB); const f32x2* ap = wsp<f32x2>(F, WS_APOW); float* kt = wsp<float>(F, WS_KTAB);
    for (int item = blockIdx.x; item < DEPTH * NG * 4; item += F.G) { const int lg = item >> 2, part = item & 3;
        __syncthreads();
        { float c_[2][4]; f32x2 a_[5];
#pragma unroll
          for (int q = 0; q < 2; ++q) { const int i = q * NTHREADS + F.tid, p = i >> 4, h = i & 15; c_[q][0] = F.in[7][(size_t)lg * 1024 + i]; c_[q][1] = F.in[8][(size_t)lg * 1024 + i];
              c_[q][2] = sb[((size_t)lg * SP + p) * 32 + h]; c_[q][3] = sb[((size_t)lg * SP + p) * 32 + 16 + h]; }
#pragma unroll
          for (int q = 0; q < 5; ++q) { const int i = q * NTHREADS + F.tid; a_[q] = ap[(size_t)lg * SP * 33 + (i < SP * 33 ? i : 0)]; }
#pragma unroll
          for (int q = 0; q < 2; ++q) { const int i = q * NTHREADS + F.tid; Cr[i] = c_[q][0]; Ci[i] = c_[q][1]; Br[i] = c_[q][2]; Bi[i] = c_[q][3]; }
#pragma unroll
          for (int q = 0; q < 5; ++q) { const int i = q * NTHREADS + F.tid; if (i < SP * 33) Ap[i] = a_[q]; } }
        __syncthreads();
        for (int e = part * 2048 + F.tid; e < (part + 1) * 2048; e += NTHREADS) { const int j = e >> 8, h = (e >> 4) & 15, hp = e & 15; float acc = 0.f;
            for (int p = 0; p < SP; ++p) { const f32x2 a = Ap[p * 33 + j]; const float br = Br[p * 16 + hp], bi = Bi[p * 16 + hp]; const float wr = a[0] * br - a[1] * bi, wi = a[0] * bi + a[1] * br;
                acc += Cr[h * 64 + p] * wr - Ci[h * 64 + p] * wi; }
            kt[(size_t)lg * 8192 + e] = acc; }
    }
}
__device__ __forceinline__ void expand_body(const Frame& F, const float* __restrict__ sb, const f32x2* __restrict__ ap, const float* __restrict__ kt, const float* __restrict__ cre, const float* __restrict__ cim,
                                            bf16* __restrict__ TZ, bf16* __restrict__ PZ) {
    const int gt = blockIdx.x * NTHREADS + F.tid, gs = F.G * NTHREADS;
    constexpr int NA = DEPTH * NG * 512 * 64, NB = DEPTH * NG * 512 * 16, NC = DEPTH * 16 * 256 * 160;
#pragma unroll 4
    for (int q = gt; q < NA; q += gs) { const int kp = q & 63, n = (q >> 6) & 511, lg = q >> 15; const int k0 = kp * 8, t = n >> 4, h = n & 15, s_ = k0 >> 4, h0 = k0 & 15;
        const bool on = t >= s_; const float* kp2 = kt + ((size_t)lg * 32 + (on ? t - s_ : 0)) * 256 + h * 16 + h0; const f32x4 a = *(const f32x4*)kp2, b = *(const f32x4*)(kp2 + 4);
        u32x4 w; w.x = pk2(a[0], a[1]); w.y = pk2(a[2], a[3]); w.z = pk2(b[0], b[1]); w.w = pk2(b[2], b[3]); if (!on) w = (u32x4){0u, 0u, 0u, 0u};
        *(u32x4*)(TZ + ((size_t)lg * 512 + n) * UK + k0) = w; }
#pragma unroll 2
    for (int q = gt; q < NB; q += gs) { const int kp = q & 15, n = (q >> 4) & 511, lg = q >> 13; const int kk = kp * 8, t = n >> 4, h = n & 15, cpart = kk >> 6, p0 = kk & 63; float v[8];
#pragma unroll
        for (int j = 0; j < 8; ++j) { const int p = p0 + j; const f32x2 a = ap[((size_t)lg * SP + p) * 33 + t + 1]; const float cr = cre[((size_t)lg * 16 + h) * SP + p], ci = cim[((size_t)lg * 16 + h) * SP + p];
            v[j] = cpart == 0 ? (cr * a[0] - ci * a[1]) : -(cr * a[1] + ci * a[0]); }
        u32x4 w; w.x = pk2(v[0], v[1]); w.y = pk2(v[2], v[3]); w.z = pk2(v[4], v[5]); w.w = pk2(v[6], v[7]);
        *(u32x4*)(TZ + ((size_t)lg * 512 + n) * UK + 512 + kk) = w; }
#pragma unroll 2
    for (int q = gt; q < NC; q += gs) { const int kp = q % 160, n = (q / 160) & 255, lp = q / (160 * 256); const int l = lp >> 4, pair = lp & 15;
        const int k0 = kp * 8, half = n >> 7, cpart = (n >> 6) & 1, p = n & 63, g = 2 * pair + half, krel = k0 - half * UK; const bool on = krel >= 0 && krel < 512; const int kr = on ? krel : 0;
        const int s_ = kr >> 4, h0 = kr & 15; const size_t gp = (size_t)(l * NG + g) * SP + p; const f32x2 wz = ap[gp * 33 + 31 - s_]; float v[8];
        const f32x4 br0 = *(const f32x4*)(sb + gp * 32 + h0), br1 = *(const f32x4*)(sb + gp * 32 + h0 + 4), bi0 = *(const f32x4*)(sb + gp * 32 + 16 + h0), bi1 = *(const f32x4*)(sb + gp * 32 + 16 + h0 + 4);
#pragma unroll
        for (int j = 0; j < 8; ++j) { const float br = j < 4 ? br0[j & 3] : br1[j & 3], bi = j < 4 ? bi0[j & 3] : bi1[j & 3]; v[j] = cpart == 0 ? (wz[0] * br - wz[1] * bi) : (wz[0] * bi + wz[1] * br); }
        u32x4 w; w.x = pk2(v[0], v[1]); w.y = pk2(v[2], v[3]); w.z = pk2(v[4], v[5]); w.w = pk2(v[6], v[7]); if (!on) w = (u32x4){0u, 0u, 0u, 0u};
        *(u32x4*)(PZ + ((size_t)lp * 256 + n) * 1280 + k0) = w; }
}
__device__ __forceinline__ void expand_phase(const Frame& F) {
    expand_body(F, wsp<float>(F, WS_SSMB), wsp<f32x2>(F, WS_APOW), wsp<float>(F, WS_KTAB), F.in[7], F.in[8], wsp<bf16>(F, WS_TZ), wsp<bf16>(F, WS_PZ));
}

__device__ __forceinline__ void ld4(const bf16* p, float (&v)[4]) { const u32x2 w = *(const u32x2*)p; v[0] = bflo(w.x); v[1] = bfhi(w.x); v[2] = bflo(w.y); v[3] = bfhi(w.y); }
__device__ __forceinline__ void poolconv_body(const Frame& F, int l, int item, const bf16* __restrict__ proj, bf16* __restrict__ mix) {
    const int lane = F.lane, c4 = lane * 4, tok0 = item * 32, pos0 = tok0 & (SEQ - 1), w = 2 << (lane >> 4);
    const bf16* base = proj + (size_t)tok0 * INW + c4;
    float cw[3][4], ps[4];
#pragma unroll
    for (int k = 0; k < 3; ++k) { const f32x4 t = *(const f32x4*)(F.in[15] + (l * 3 + k) * 256 + c4); cw[k][0] = t[0]; cw[k][1] = t[1]; cw[k][2] = t[2]; cw[k][3] = t[3]; }
    { const f32x4 t = *(const f32x4*)(F.in[14] + l * 256 + c4); ps[0] = t[0]; ps[1] = t[1]; ps[2] = t[2]; ps[3] = t[3]; }
    float z2[4] = {0.f, 0.f, 0.f, 0.f}, z1[4] = {0.f, 0.f, 0.f, 0.f}, ws[4] = {0.f, 0.f, 0.f, 0.f};
    if (pos0 > 0) {
        float a[4], b[4];
        ld4(base - 2 * INW + 1024, a); ld4(base - 2 * INW + 1280, b);
#pragma unroll
        for (int j = 0; j < 4; ++j) z2[j] = a[j] * b[j];
        ld4(base - 1 * INW + 1024, a); ld4(base - 1 * INW + 1280, b);
#pragma unroll
        for (int j = 0; j < 4; ++j) z1[j] = a[j] * b[j];
        { u32x2 hq[16];
#pragma unroll
          for (int k = 1; k <= 16; ++k) hq[k - 1] = *(const u32x2*)(base - k * INW + 512);
#pragma unroll
          for (int k = 1; k <= 16; ++k) { const float on = (k <= w) ? 1.0f : 0.0f; const u32x2 h_ = hq[k - 1];
              ws[0] += on * bflo(h_.x); ws[1] += on * bfhi(h_.x); ws[2] += on * bflo(h_.y); ws[3] += on * bfhi(h_.y); } }
    }
    u32x2 La[4][5], Lb[4][5];
#define PC_LOAD(L, t0) do { _Pragma("unroll") for (int tt = 0; tt < 4; ++tt) { const bf16* row = base + (size_t)((t0) + tt) * INW; const bool drop_ = (pos0 + (t0) + tt) >= w; \
        L[tt][0] = *(const u32x2*)(row + 512); L[tt][1] = *(const u32x2*)(row + 768); L[tt][2] = *(const u32x2*)(row + 1024); L[tt][3] = *(const u32x2*)(row + 1280); \
        L[tt][4] = *(const u32x2*)(drop_ ? row - w * INW + 512 : row + 512); } } while (0)
#define PC_UNPK(v, W_) do { const u32x2 w2_ = (W_); v[0] = bflo(w2_.x); v[1] = bfhi(w2_.x); v[2] = bflo(w2_.y); v[3] = bfhi(w2_.y); } while (0)
#define PC_COMP(L, t0) do { _Pragma("unroll") for (int tt = 0; tt < 4; ++tt) { const int t = (t0) + tt, pos = pos0 + t; \
        float q[4], qo[4], bg[4], cg[4], hv[4]; PC_UNPK(q, L[tt][0]); PC_UNPK(bg, L[tt][1]); PC_UNPK(cg, L[tt][2]); PC_UNPK(hv, L[tt][3]); PC_UNPK(qo, L[tt][4]); \
        const bool drop = pos >= w; const float inv = 1.0f / (float)((pos + 1) < w ? (pos + 1) : w); \
        float po[4], co[4], sp = 0.f, sc = 0.f; \
        _Pragma("unroll") for (int j = 0; j < 4; ++j) { ws[j] += q[j]; if (drop) ws[j] -= qo[j]; po[j] = (ws[j] * inv - q[j]) * ps[j]; sp += po[j] * po[j]; \
            const float z0 = cg[j] * hv[j]; co[j] = bg[j] * (cw[0][j] * z2[j] + cw[1][j] * z1[j] + cw[2][j] * z0); sc += co[j] * co[j]; z2[j] = z1[j]; z1[j] = z0; } \
        const float rp = __builtin_amdgcn_rsqf(wave_sum_dpp(sp) * (1.0f / 256) + EPS), rc = __builtin_amdgcn_rsqf(wave_sum_dpp(sc) * (1.0f / 256) + EPS); \
        u32x2 wa; wa.x = pk2(po[0] * rp, po[1] * rp); wa.y = pk2(po[2] * rp, po[3] * rp); u32x2 wb; wb.x = pk2(co[0] * rc, co[1] * rc); wb.y = pk2(co[2] * rc, co[3] * rc); \
        if (DBG_SKIP & 4) { wa.x = 0; wa.y = 0; } if (DBG_SKIP & 8) { wb.x = 0; wb.y = 0; } \
        bf16* mr = mix + (size_t)(tok0 + t) * DM + c4; *(u32x2*)(mr + 512) = wa; *(u32x2*)(mr + 768) = wb; } } while (0)
    PC_LOAD(La, 0);
    for (int t0 = 0; t0 < 32; t0 += 8) {
        PC_LOAD(Lb, t0 + 4);
        PC_COMP(La, t0);
        if (t0 + 8 < 32) PC_LOAD(La, t0 + 8);
        PC_COMP(Lb, t0 + 4);
    }
#undef PC_LOAD
#undef PC_UNPK
#undef PC_COMP
}
__device__ __forceinline__ void poolconv_item(const Frame& F, int l, int item) { poolconv_body(F, l, item, wsp<bf16>(F, WS_PROJ), wsp<bf16>(F, WS_MIX)); }

__device__ __forceinline__ void ssm_carry_lds(const Frame& F, int l, int b, int g) {
    bf16* UB = wsp<bf16>(F, WS_UB);
    const LAS float* Sl = (const LAS float*)F.lds; LAS f32x2* ends = (LAS f32x2*)(F.lds + MISC_OFF + 6144);
    const int p = F.tid & 63, seg = F.tid >> 6;
    const f32x4 a = wsp<f32x4>(F, WS_SSMA)[(l * NG + g) * SP + p]; const float Ar = a[2], Ai = a[3];
    __syncthreads();
    float pr[32], pi[32]; float hr = 0.f, hi = 0.f;
#pragma unroll
    for (int j = 0; j < 32; ++j) { pr[j] = Sl[(seg * 32 + j) * SPITCH + p]; pi[j] = Sl[(seg * 32 + j) * SPITCH + 64 + p]; }
#pragma unroll
    for (int j = 0; j < 32; ++j) { const float sr = pr[j], si = pi[j]; pr[j] = hr; pi[j] = hi;
        const float nr = Ar * hr - Ai * hi + sr, ni = Ar * hi + Ai * hr + si; hr = nr; hi = ni; }
    ends[seg * 64 + p] = (f32x2){hr, hi};
    float Br = Ar, Bi = Ai;
#pragma unroll
    for (int q = 0; q < 5; ++q) { const float t = Br * Br - Bi * Bi; Bi = 2.0f * Br * Bi; Br = t; }
    __syncthreads();
    float gr = 0.f, gi = 0.f;
    for (int q = 0; q < seg; ++q) { const f32x2 e = ends[q * 64 + p]; const float nr = Br * gr - Bi * gi + e[0], ni = Br * gi + Bi * gr + e[1]; gr = nr; gi = ni; }
#pragma unroll
    for (int j = 0; j < 32; ++j) { const unsigned o = (unsigned)(((b * NCH + seg * 32 + j) * NG + g) * UK + 512 + p);
        const float vr = gr + pr[j], vi = gi + pi[j];
        UB[o] = (bf16)(pk2(vr, vr) & 0xffffu); UB[o + 64] = (bf16)(pk2(vi, vi) & 0xffffu);
        const float nr = Ar * gr - Ai * gi, ni = Ar * gi + Ai * gr; gr = nr; gi = ni; }
}

constexpr int RW_PITCH = 2064;
__device__ __forceinline__ float row16_max(float v, int ln) { v = fmaxf(v, shx(v, 1, ln)); v = fmaxf(v, shx(v, 2, ln)); v = fmaxf(v, shx(v, 4, ln)); v = fmaxf(v, shx(v, 8, ln)); return v; }
__device__ __forceinline__ int row16_min(int v, int ln) { int t; t = shxi(v, 1, ln); v = t < v ? t : v; t = shxi(v, 2, ln); v = t < v ? t : v; t = shxi(v, 4, ln); v = t < v ? t : v; t = shxi(v, 8, ln); v = t < v ? t : v; return v; }
__device__ __forceinline__ void route_phase(const Frame& F, int l, const bf16* X1) {
    LAS unsigned char* Wh = F.lds; LAS unsigned char* Wl = F.lds + 32 * RW_PITCH;
    LAS int* lcount = (LAS int*)(F.lds + MISC_OFF + 512); LAS int* gbase = (LAS int*)(F.lds + MISC_OFF + 640);
    LAS u32x2* tokrec = (LAS u32x2*)(F.lds + MISC_OFF + 1024);
    LAS float* rsl = (LAS float*)(F.lds + MISC_OFF + 5120);
    const float* wr = wsp<float>(F, WS_WR) + (size_t)l * NE * DM; const float* rb = F.in[20] + l * NE;
    float* rowg = wsp<float>(F, WS_ROWG); float* rowr = wsp<float>(F, WS_ROWR); int* rowl = wsp<int>(F, WS_ROWL);
    unsigned* gcount = wsp<unsigned>(F, WS_CTL) + CW_CNT + l * NE;
    f32x4 wv_[NE * DM / (NTHREADS * 4)];
#pragma unroll
    for (int q = 0; q < NE * DM / (NTHREADS * 4); ++q) wv_[q] = *(const f32x4*)(wr + (q * NTHREADS + F.tid) * 4);
#pragma unroll
    for (int q = 0; q < NE * DM / (NTHREADS * 4); ++q) { const int i = (q * NTHREADS + F.tid) * 4; const f32x4 w = wv_[q]; const int e = i >> 10, k = i & 1023;
        const unsigned h0 = pk2(w[0], w[1]), h1 = pk2(w[2], w[3]);
        const unsigned l0 = pk2(w[0] - bflo(h0), w[1] - bfhi(h0)), l1 = pk2(w[2] - bflo(h1), w[3] - bfhi(h1));
        *(LAS u32x2*)(Wh + e * RW_PITCH + k * 2) = (u32x2){h0, h1}; *(LAS u32x2*)(Wl + e * RW_PITCH + k * 2) = (u32x2){l0, l1}; }
    if (F.tid < 32) lcount[F.tid] = 0;
    __syncthreads();
    const int lane = F.lane, tr = lane & 15, kq = lane >> 4;
    const float b0 = rb[tr], b1 = rb[tr + 16];
    for (int batch = blockIdx.x; batch < NTOK / 128; batch += F.G) {
        const int tok0 = batch * 128 + F.wave * 16;
        f32x4 d0 = {0.f, 0.f, 0.f, 0.f}, d1 = {0.f, 0.f, 0.f, 0.f}; float ssq = 0.f;
        const bf16* xp = X1 + (size_t)(tok0 + tr) * DM + kq * 8;
        const LAS unsigned char* whp = Wh + tr * RW_PITCH + kq * 16; const LAS unsigned char* wlp = Wl + tr * RW_PITCH + kq * 16;
        u32x4 xrow[32];
#pragma unroll
        for (int ks = 0; ks < 32; ++ks) xrow[ks] = *(const u32x4*)(xp + ks * 32);
#pragma unroll
        for (int ks = 0; ks < 32; ++ks) {
            const u32x4 xh = xrow[ks];
            { const float f0 = bflo(xh.x), f1 = bfhi(xh.x), f2 = bflo(xh.y), f3 = bfhi(xh.y), f4 = bflo(xh.z), f5 = bfhi(xh.z), f6 = bflo(xh.w), f7 = bfhi(xh.w);
              ssq += ((f0 * f0 + f1 * f1) + (f2 * f2 + f3 * f3)) + ((f4 * f4 + f5 * f5) + (f6 * f6 + f7 * f7)); }
            const bf16x8 ah = __builtin_bit_cast(bf16x8, xh);
            const bf16x8 wh0 = *(const LAS bf16x8*)(whp + ks * 64), wh1 = *(const LAS bf16x8*)(whp + 16 * RW_PITCH + ks * 64);
            const bf16x8 wl0 = *(const LAS bf16x8*)(wlp + ks * 64), wl1 = *(const LAS bf16x8*)(wlp + 16 * RW_PITCH + ks * 64);
            d0 = __builtin_amdgcn_mfma_f32_16x16x32_bf16(ah, wh0, d0, 0, 0, 0); d1 = __builtin_amdgcn_mfma_f32_16x16x32_bf16(ah, wh1, d1, 0, 0, 0);
            d0 = __builtin_amdgcn_mfma_f32_16x16x32_bf16(ah, wl0, d0, 0, 0, 0); d1 = __builtin_amdgcn_mfma_f32_16x16x32_bf16(ah, wl1, d1, 0, 0, 0);
        }
        ssq += shx(ssq, 16, lane); ssq += shx(ssq, 32, lane);
        const float rstd = __builtin_amdgcn_rsqf(ssq * (1.0f / DM) + EPS);
#pragma unroll
        for (int r = 0; r < 4; ++r) { const int ti = 4 * kq + r; const float rs = shl_(rstd, ti);
            float v0 = d0[r] * rs + b0, v1 = d1[r] * rs + b1; int es[4]; float tv[4];
#pragma unroll
            for (int k = 0; k < 4; ++k) { const float mx = row16_max(fmaxf(v0, v1), lane); const int cand = (v0 == mx) ? tr : ((v1 == mx) ? tr + 16 : 1000); const int em = row16_min(cand, lane);
                es[k] = em; tv[k] = mx; v0 = (tr == em) ? -3.0e38f : v0; v1 = (tr + 16 == em) ? -3.0e38f : v1; }
            float p[4], sum = 0.f;
#pragma unroll
            for (int k = 0; k < 4; ++k) { p[k] = __expf(tv[k] - tv[0]); sum += p[k]; }
            const float inv = 1.0f / sum;
            if (tr < 4) { const int ee = tr == 0 ? es[0] : tr == 1 ? es[1] : tr == 2 ? es[2] : es[3]; const float gg = (tr == 0 ? p[0] : tr == 1 ? p[1] : tr == 2 ? p[2] : p[3]) * inv;
                const int slot = __hip_atomic_fetch_add(lcount + ee, 1, __ATOMIC_RELAXED, __HIP_MEMORY_SCOPE_WORKGROUP);
                u32x2 rec; rec.x = (unsigned)ee | ((unsigned)slot << 8); rec.y = __float_as_uint(gg);
                tokrec[(F.wave * 16 + ti) * 4 + tr] = rec; }
            if (tr == 4) rsl[F.wave * 16 + ti] = rs;
        }
#if GU_FP6A
        { LDS_WAIT(); const bool hi = lane >= 32; const int b = lane & 31; const bf16* xb0 = X1 + (size_t)(tok0 + (hi ? 1 : 0)) * DM + b * 32;
          u32x4 xr[8][4];
#pragma unroll
          for (int it = 0; it < 8; ++it)
#pragma unroll
              for (int q = 0; q < 4; ++q) xr[it][q] = *(const u32x4*)(xb0 + (size_t)(2 * it) * DM + q * 8);
          unsigned char* x6 = wsp<unsigned char>(F, WS_XQ);
#pragma unroll
          for (int it = 0; it < 8; ++it) {
              typedef unsigned short us2 __attribute__((ext_vector_type(2)));
              us2 mx = {0, 0};
#pragma unroll
              for (int q = 0; q < 4; ++q) { const u32x4 xh = xr[it][q];
#pragma unroll
                  for (int j = 0; j < 4; ++j) { const us2 a = __builtin_bit_cast(us2, xh[j] & 0x7fff7fffu); mx = __builtin_elementwise_max(mx, a); } }
              float am = __uint_as_float((unsigned)(mx[0] > mx[1] ? mx[0] : mx[1]) << 16);
              am = half_max_dpp(am, hi);
              const unsigned vb = __float_as_uint(am * (1.0f / 7.5f)); const unsigned e2 = ((vb >> 23) & 255u) + ((vb & 0x7fffffu) ? 1u : 0u);
              const bool ok = am > 0.f && e2 >= 1u && e2 <= 253u; const float s2 = ok ? __uint_as_float(e2 << 23) : 1.0f;
              typedef unsigned u32x16 __attribute__((ext_vector_type(16))); typedef __bf16 b32v __attribute__((ext_vector_type(32)));
              const u32x16 wv = {xr[it][0].x, xr[it][0].y, xr[it][0].z, xr[it][0].w, xr[it][1].x, xr[it][1].y, xr[it][1].z, xr[it][1].w, xr[it][2].x, xr[it][2].y, xr[it][2].z, xr[it][2].w, xr[it][3].x, xr[it][3].y, xr[it][3].z, xr[it][3].w};
              const u32x6 pk = __builtin_amdgcn_cvt_scalef32_pk32_fp6_bf16(__builtin_bit_cast(b32v, wv), s2);
              const int tokq = tok0 + 2 * it + (hi ? 1 : 0); unsigned char* d = x6 + (size_t)tokq * X6ROW + (b >> 2) * X6KT;
              *(u32x4*)(d + (b & 3) * 16) = (u32x4){pk[0], pk[1], pk[2], pk[3]}; *(u32x2*)(d + 64 + (b & 3) * 8) = (u32x2){pk[4], pk[5]};
              if (b == 0) rsl[F.wave * 16 + 2 * it + (hi ? 1 : 0)] *= s2;
              asm volatile("" ::: "memory"); } }
#endif
        __syncthreads();
        if (F.tid < 32) gbase[F.tid] = (int)__hip_atomic_fetch_add(gcount + F.tid, (unsigned)lcount[F.tid], __ATOMIC_RELAXED, __HIP_MEMORY_SCOPE_AGENT);
        __syncthreads();
        { const u32x2 rec = tokrec[F.tid]; const int e = rec.x & 0xff, slot = gbase[e] + (int)(rec.x >> 8); const int tokk = batch * 512 + F.tid;
          rowl[(size_t)e * ROWCAP + slot] = tokk; rowg[(size_t)e * ROWCAP + slot] = __uint_as_float(rec.y); rowr[(size_t)e * ROWCAP + slot] = rsl[F.tid >> 2]; }
        __syncthreads();
        if (F.tid < 32) lcount[F.tid] = 0;
        __syncthreads();
    }
}
__device__ __forceinline__ void expert_tables(const Frame& F, int l) {
    LAS int* ecnt = (LAS int*)(F.lds + MISC_OFF + 64); LAS int* mbpre = (LAS int*)(F.lds + MISC_OFF + 192);
    const unsigned* gcount = wsp<unsigned>(F, WS_CTL) + CW_CNT + l * NE;
    unsigned tz = (unsigned)F.tid; asm volatile("" : "+v"(tz));
    if (tz < 32) ecnt[tz] = (int)__hip_atomic_load(gcount + tz, __ATOMIC_RELAXED, __HIP_MEMORY_SCOPE_AGENT);
    __syncthreads();
    if (F.wave == 0) {
        const int ln = lane_id_now(); const int c = ln < NE ? (ecnt[ln & 31] + 255) >> 8 : 0; int v = c;
        v += __builtin_amdgcn_update_dpp(0, v, 0x111, 0xf, 0xf, true); v += __builtin_amdgcn_update_dpp(0, v, 0x112, 0xf, 0xf, true);
        v += __builtin_amdgcn_update_dpp(0, v, 0x114, 0xf, 0xf, true); v += __builtin_amdgcn_update_dpp(0, v, 0x118, 0xf, 0xf, true);
        v += __builtin_amdgcn_update_dpp(0, v, 0x142, 0xa, 0xf, false);
        if (ln < NE) mbpre[ln] = v - c;
        if (ln == NE - 1) mbpre[NE] = v; }
    __syncthreads();
}
__device__ __forceinline__ void combine_phase(const Frame& F, int l, const bf16* X1) {
    const unsigned char* Y = wsp<unsigned char>(F, WS_Y); bf16* xb = wsp<bf16>(F, WS_XBF); float* rs = wsp<float>(F, WS_RSTD0); unsigned char* xq = wsp<unsigned char>(F, WS_XQ);
    const bool lastl = (l == DEPTH - 1); const int col = 16 * F.lane;
    f32x4 gfin[4];
    if (lastl) {
#pragma unroll
        for (int q = 0; q < 4; ++q) gfin[q] = *(const f32x4*)(F.in[25] + col + 4 * q); }
    auto load6 = [&](u32x4 (&L)[6], const int tok) __attribute__((always_inline)) {
        L[0] = *(const u32x4*)(X1 + (size_t)tok * DM + col); L[1] = *(const u32x4*)(X1 + (size_t)tok * DM + col + 8);
#pragma unroll
        for (int k = 0; k < 4; ++k) L[2 + k] = *(const u32x4*)(Y + ((size_t)tok * 4 + k) * DM + col); };
    auto process = [&](const u32x4 (&L)[6], const int tok) __attribute__((always_inline)) { float v[16]; float ss = 0.f;
        { const u32x4 a = L[0], b = L[1];
          v[0] = bflo(a.x); v[1] = bfhi(a.x); v[2] = bflo(a.y); v[3] = bfhi(a.y); v[4] = bflo(a.z); v[5] = bfhi(a.z); v[6] = bflo(a.w); v[7] = bfhi(a.w);
          v[8] = bflo(b.x); v[9] = bfhi(b.x); v[10] = bflo(b.y); v[11] = bfhi(b.y); v[12] = bflo(b.z); v[13] = bfhi(b.z); v[14] = bflo(b.w); v[15] = bfhi(b.w); }
#pragma unroll
        for (int k = 0; k < ((DBG_SKIP & 1) ? 0 : 4); ++k) { const u32x4 y = L[2 + k];
#pragma unroll
            for (int q = 0; q < 4; ++q) { const int w = (int)y[q]; const f32x2 lo = __builtin_amdgcn_cvt_pk_f32_fp8(w, false), hi = __builtin_amdgcn_cvt_pk_f32_fp8(w, true);
                v[4 * q + 0] += lo[0] * Y8_INV; v[4 * q + 1] += lo[1] * Y8_INV; v[4 * q + 2] += hi[0] * Y8_INV; v[4 * q + 3] += hi[1] * Y8_INV; } }
#pragma unroll
        for (int j = 0; j < 16; ++j) ss += v[j] * v[j];
        const float r = __builtin_amdgcn_rsqf(wave_sum_dpp(ss) * (1.0f / DM) + EPS);
        if (!lastl) {
            u32x4 a, b; a.x = pk2(v[0], v[1]); a.y = pk2(v[2], v[3]); a.z = pk2(v[4], v[5]); a.w = pk2(v[6], v[7]); b.x = pk2(v[8], v[9]); b.y = pk2(v[10], v[11]); b.z = pk2(v[12], v[13]); b.w = pk2(v[14], v[15]);
            *(u32x4*)(xb + (size_t)tok * DM + col) = a; *(u32x4*)(xb + (size_t)tok * DM + col + 8) = b;
            float am = 0.f;
#pragma unroll
            for (int j = 0; j < 16; ++j) am = fmaxf(am, fabsf(v[j]));
            am = wave_max_dpp(am); const float sc = am > 0.f ? am * (1.0f / 127.0f) : 1.0f, qs = 1.0f / sc;
            u32x4 qv;
#pragma unroll
            for (int q = 0; q < 4; ++q) qv[q] = pk4_i8(v[4 * q] * qs, v[4 * q + 1] * qs, v[4 * q + 2] * qs, v[4 * q + 3] * qs);
            *(u32x4*)(xq + (size_t)tok * DM + col) = qv;
            if (F.lane == 0) rs[tok] = r * sc;
        } else {
#pragma unroll
            for (int q = 0; q < 4; ++q) { const f32x4 g = gfin[q];
                *(f32x4*)(F.out + (size_t)tok * DM + col + 4 * q) = (f32x4){v[4 * q] * r * g[0], v[4 * q + 1] * r * g[1], v[4 * q + 2] * r * g[2], v[4 * q + 3] * r * g[3]}; }
        } };
    u32x4 La[6], Lb[6];
    int tok = F.gw; if (tok < NTOK) load6(La, tok);
    while (tok < NTOK) {
        const int tn = tok + F.ngw; if (tn < NTOK) load6(Lb, tn);
        process(La, tok);
        if (tn >= NTOK) break;
        const int t2 = tn + F.ngw; if (t2 < NTOK) load6(La, t2);
        process(Lb, tn);
        tok = t2; }
}

constexpr int PH_PER_LAYER = 10, NPRO = 3, NPHASES = NPRO + DEPTH * PH_PER_LAYER;
struct Args { const float* in[26]; float* out; unsigned char* ws; int ph_lo, ph_hi, flags, pad; };
__global__ void __launch_bounds__(NTHREADS, 2) fwd(Args args) {
    extern __shared__ __attribute__((aligned(16))) unsigned char lds_raw[];
    Frame F;
    F.lds = (LAS unsigned char*)lds_raw;
    F.tid = threadIdx.x; F.lane = F.tid & 63; F.wave = __builtin_amdgcn_readfirstlane(F.tid >> 6);
    F.G = gridDim.x; F.gw = blockIdx.x * NWAVES + F.wave; F.ngw = F.G * NWAVES;
#pragma unroll
    for (int i = 0; i < 26; ++i) F.in[i] = args.in[i];
    F.out = args.out; F.ws = args.ws;
    volatile LAS unsigned* bst = (volatile LAS unsigned*)(F.lds + MISC_OFF);
    if (F.tid < 4) bst[F.tid] = 0u;
    __syncthreads();
    const int lo = args.ph_lo, hi = args.ph_hi;
    XcdBarrier bar; bar.bar = wsp<unsigned>(F, WS_CTL) + CW_BAR; bar.x = 0; bar.st = bst;
    if (hi - lo > 1) bar = xcd_barrier_post(wsp<unsigned>(F, WS_CTL) + CW_BAR, bst);
#ifndef PH_MASK
#define PH_MASK 0x7ff
#endif
#define INL(k, j) ((PH_MASK >> (j)) & 1) && (lo <= (k) && (k) < hi)
#define IN(k) (lo <= (k) && (k) < hi)
#define SEAM(k) do { if (IN(k) && IN((k) + 1)) xcd_barrier(bar, F.wave == 0 && lane_id_now() == 0); } while (0)
    LAS int* ecnt = (LAS int*)(F.lds + MISC_OFF + 64); LAS int* mbpre = (LAS int*)(F.lds + MISC_OFF + 192);

#define PHASE_FRAME() Frame Fp = F; asm volatile("" : "+s"(Fp.wave), "+s"(Fp.gw)); Fp.lane = lane_id_now(); Fp.tid = Fp.wave * 64 + Fp.lane
    if (INL(0, 0)) { PHASE_FRAME(); prologue_phase(Fp); } SEAM(0);
    if (INL(1, 0)) { PHASE_FRAME(); winq_phase(Fp); __syncthreads(); ktab_phase(Fp); } SEAM(1);
    if (INL(2, 0)) { PHASE_FRAME(); expand_phase(Fp); }
#if !MK_ONE_LAUNCH
    SEAM(2);
#endif
    for (int l = 0; l < DEPTH; ++l) {
        const int p0 = NPRO + l * PH_PER_LAYER;
        const unsigned char* wl = F.ws + WS_W + (size_t)l * WL_STRIDE;

        if (INL(p0 + 0, 1)) { PHASE_FRAME();
            ProbInProj pb; pb.A = wsp<bf16>(Fp, WS_XQ); pb.Bt = (const bf16*)(wl + WL_IN); pb.lda = DM / 2; pb.ldb = DM / 2; pb.nM = NTOK / 256; pb.nN = INW / 256; pb.G = Fp.G; pb.c = blockIdx.x; pb.nt = DM / 128;
            pb.rowsc = wsp<float>(Fp, WS_RSTD0); pb.sw = wsp<float>(Fp, WS_SWIN) + l * INW; pb.O = wsp<bf16>(Fp, WS_PROJ); pb.UB = wsp<bf16>(Fp, WS_UB);
            pg8::gemm_phase(Fp.lds, pb, Fp.tid, (args.flags & 1) != 0);
        } SEAM(p0 + 0);
        if (INL(p0 + 1, 2)) { PHASE_FRAME();
            if (blockIdx.x < 128 && Fp.G > 128) {
                ProbSState pb; pb.UB = wsp<bf16>(Fp, WS_UB); pb.PZ = wsp<bf16>(Fp, WS_PZ) + (size_t)l * 16 * 256 * 1280; pb.Sl = (LAS float*)Fp.lds; pb.c = blockIdx.x; pb.nt = SSMW / 64; pb.ldb = 1280;
                pg8::gemm_phase(Fp.lds, pb, Fp.tid, false);
                ssm_carry_lds(Fp, l, (blockIdx.x >> 3) & 3, (blockIdx.x & 7) * 4 + (blockIdx.x >> 5));
            } else { const int nw = (Fp.G - 128) * NWAVES; for (int item = (blockIdx.x - 128) * NWAVES + Fp.wave; item < NTOK / 32; item += nw) poolconv_item(Fp, l, item); }
        } SEAM(p0 + 1);
        if (INL(p0 + 3, 4)) { PHASE_FRAME();
            ProbSsmOut pb; pb.UB = wsp<bf16>(Fp, WS_UB); pb.TZ = wsp<bf16>(Fp, WS_TZ) + (size_t)l * NG * 512 * UK; pb.dsk = Fp.in[9] + l * SSMW; pb.Z = wsp<bf16>(Fp, WS_Z); pb.G = Fp.G; pb.c = blockIdx.x; pb.nt = UK / 64; pb.ldb = UK;
            pg8::gemm_phase(Fp.lds, pb, Fp.tid, (args.flags & 1) != 0);
        } SEAM(p0 + 3);
        if (INL(p0 + 4, 5)) { PHASE_FRAME();
            ProbGlu pb; pb.A = wsp<bf16>(Fp, WS_Z); pb.Bt = (const bf16*)(wl + WL_GLU); pb.lda = SSMW; pb.ldb = SSMW; pb.nM = NTOK / 256; pb.nN = 2; pb.G = Fp.G; pb.c = blockIdx.x; pb.nt = SSMW / 64;
            pb.Z = wsp<bf16>(Fp, WS_Z); pb.bias = Fp.in[12] + l * SSMW; pb.O = wsp<bf16>(Fp, WS_MIX); pb.ssqp = wsp<float>(Fp, WS_SSQP);
            pg8::gemm_phase(Fp.lds, pb, Fp.tid, (args.flags & 1) != 0);
        } SEAM(p0 + 4);
        if (INL(p0 + 5, 6)) { PHASE_FRAME();
            ProbOutProj pb; pb.A = wsp<bf16>(Fp, WS_MIX); pb.Bt = (const bf16*)(wl + WL_OUT); pb.lda = DM; pb.ldb = DM; pb.nM = NTOK / 256; pb.nN = 4; pb.G = Fp.G; pb.c = blockIdx.x; pb.nt = DM / 64;
            pb.xres = wsp<bf16>(Fp, WS_XBF); pb.X1b = wsp<bf16>(Fp, WS_XBF1); pb.X1q = wsp<unsigned char>(Fp, WS_XQ);
            { LAS float* rsT = (LAS float*)(Fp.lds + MISC_OFF + 6144); pb.rsT = rsT;
              const float* ssqp = wsp<float>(Fp, WS_SSQP); const int rl = Fp.tid & 255;
#pragma unroll
              for (int ui = 0; ui < 2; ++ui) { Unit u;
                  if (pb.next(ui, u) && (Fp.wave >> 2) == ui) { const unsigned row = (unsigned)(u.pm * 256 + rl); const f32x4 p0 = *(const f32x4*)(ssqp + row * 8), p1 = *(const f32x4*)(ssqp + row * 8 + 4);
                      rsT[ui * 256 + rl] = __builtin_amdgcn_rsqf((((p0[0] + p0[1]) + (p0[2] + p0[3])) + ((p1[0] + p1[1]) + (p1[2] + p1[3]))) * (1.0f / SSMW) + EPS); } }
              __syncthreads(); }
            pg8::gemm_phase(Fp.lds, pb, Fp.tid, (args.flags & 1) != 0);
        } SEAM(p0 + 5);
        if (INL(p0 + 6, 7)) { PHASE_FRAME(); route_phase(Fp, l, wsp<bf16>(Fp, WS_XBF1)); } SEAM(p0 + 6);
        if (INL(p0 + 7, 8)) { PHASE_FRAME();
            expert_tables(Fp, l);
            ProbGateUp pb; pb.ecnt = ecnt; pb.mbpre = mbpre; pb.mt = Fp.lds + MISC_OFF + 1024; pb.NT = 8; pb.G = Fp.G; pb.c = blockIdx.x; pb.nt = DM / 128; pb.ldb = DM / 2;
            pb.X = wsp<unsigned char>(Fp, WS_XQ); pb.Wt = wl + WL_GU; pb.rowl = wsp<int>(Fp, WS_ROWL); pb.rowr = wsp<float>(Fp, WS_ROWR); pb.bgu = Fp.in[22] + (size_t)l * NE * 2048; pb.H = wsp<unsigned char>(Fp, WS_H);
            if constexpr (RING3 && GU_FP6 && GU_FP6A) pg8::gemm_phase6(Fp.lds, pb, Fp.tid, (args.flags & 1) != 0); else pg8::gemm_phase(Fp.lds, pb, Fp.tid, (args.flags & 1) != 0);
        } SEAM(p0 + 7);
        if (INL(p0 + 8, 9)) { PHASE_FRAME();
            expert_tables(Fp, l);
            ProbDown pb; pb.ecnt = ecnt; pb.mbpre = mbpre; pb.mt = Fp.lds + MISC_OFF + 1024; pb.NT = 4; pb.G = Fp.G; pb.c = blockIdx.x; pb.nt = DM / 128; pb.ldb = DM / 2;
            pb.Hm = wsp<unsigned char>(Fp, WS_H); pb.Wt = wl + WL_DN; pb.rowl = wsp<int>(Fp, WS_ROWL); pb.gate = wsp<float>(Fp, WS_ROWG); pb.bdn = Fp.in[24] + (size_t)l * NE * DM; pb.Y = wsp<unsigned char>(Fp, WS_Y);
            if constexpr (RING3 && DN_FP6 && DN_FP6A) pg8::gemm_phase6(Fp.lds, pb, Fp.tid, (args.flags & 1) != 0); else pg8::gemm_phase(Fp.lds, pb, Fp.tid, (args.flags & 1) != 0);
        } SEAM(p0 + 8);
        if (INL(p0 + 9, 10)) { PHASE_FRAME(); combine_phase(Fp, l, wsp<bf16>(Fp, WS_XBF1)); } SEAM(p0 + 9);
    }
#undef IN
#undef SEAM
}

extern "C" void kernel_launch(void* const* d_in, const int* in_sizes, int n_in, void* d_out, int out_size, void* d_ws, size_t ws_size, hipStream_t stream) {
    static int grid = 0;
    if (grid == 0) {
        if (n_in != 26 || out_size != NTOK * DM || ws_size < WS_END) { fprintf(stderr, "kernel_launch: unexpected shapes (n_in %d out %d ws %zu need %zu)\n", n_in, out_size, ws_size, (size_t)WS_END); grid = -1; return; }
        int dev = 0, cus = 0;
        if (hipGetDevice(&dev) != hipSuccess || hipDeviceGetAttribute(&cus, hipDeviceAttributeMultiprocessorCount, dev) != hipSuccess) { grid = -1; return; }
        if (hipFuncSetAttribute((const void*)fwd, hipFuncAttributeMaxDynamicSharedMemorySize, LDS_BYTES) != hipSuccess) { fprintf(stderr, "kernel_launch: hipFuncSetAttribute failed\n"); grid = -1; return; }
        int per_cu = 0;
        if (hipOccupancyMaxActiveBlocksPerMultiprocessor(&per_cu, (const void*)fwd, NTHREADS, LDS_BYTES) != hipSuccess || per_cu < 1) fprintf(stderr, "kernel_launch: occupancy query reports %d\n", per_cu);
        (void)hipGetLastError();
        grid = cus;
    }
    if (grid < 0) return;
    (void)hipMemsetAsync((char*)d_ws + WS_CTL, 0, CTL_ZERO_BYTES, stream);
    Args a{};
    for (int i = 0; i < 26; ++i) a.in[i] = (const float*)d_in[i];
    a.out = (float*)d_out; a.ws = (unsigned char*)d_ws;
#if defined(PROBE_DUP)
    for (int p = 0; p < NPHASES; ++p) { const int slot = p < NPRO ? 0 : 1 + (p - NPRO) % PH_PER_LAYER; const int reps = ((PROBE_DUP >> slot) & 1) ? 2 : 1;
        for (int r = 0; r < reps; ++r) { a.ph_lo = p; a.ph_hi = p + 1; a.flags = (r > 0) ? PROBE_FLAGS : 0; hipLaunchKernelGGL(fwd, dim3(grid), dim3(NTHREADS), LDS_BYTES, stream, a); } }
#elif MK_ONE_LAUNCH
    a.ph_lo = 0; a.ph_hi = NPHASES;
    hipLaunchKernelGGL(fwd, dim3(grid), dim3(NTHREADS), LDS_BYTES, stream, a);
#else
    for (int p = 0; p < NPHASES; ++p) { a.ph_lo = p; a.ph_hi = p + 1; hipLaunchKernelGGL(fwd, dim3(grid), dim3(NTHREADS), LDS_BYTES, stream, a); }
#endif
}
```
